# Optimizing an MI355X kernel written in HIP

```python
import math
import jax, jax.numpy as jnp
from jax import lax
import numpy as np

D_MODEL = 1024
BATCH = 32
SEQ = 2048
DEPTH = 4

D_MIX = D_MODEL
GLA_WIDTH = D_MIX // 2
SG_WIDTH = D_MIX - GLA_WIDTH
GLA_HEADS = 4
GLA_DK = 64
GLA_DV = GLA_WIDTH // GLA_HEADS
GLA_KW = GLA_HEADS * GLA_DK
GATE_RANK = 16
GATE_TAU = 16.0
GLA_CHUNK = 64
SG_GROUPS = 4
SG_GROUP_DIM = SG_WIDTH // SG_GROUPS
SG_CHUNK = 128
EPS = 1e-6
IN_SPLIT = (GLA_KW, GLA_KW, GLA_WIDTH, GATE_RANK, GLA_WIDTH, SG_WIDTH, SG_WIDTH, SG_WIDTH)
IN_WIDTH = sum(IN_SPLIT)

kernel_name = "hymba_style_gla_gmlp_hybrid"


def _rmsnorm(x, g):
    xf = x.astype(jnp.float32)
    y = xf * lax.rsqrt(jnp.mean(xf * xf, axis=-1, keepdims=True) + EPS)
    return (y * g.astype(jnp.float32)).astype(x.dtype)


def _gla(q, k, v, log_a):
    B, S, H, DK = q.shape
    DV = v.shape[-1]
    C = GLA_CHUNK
    N = S // C

    def to_chunks(t):
        return t.astype(jnp.float32).reshape(B, N, C, H, t.shape[-1]).transpose(1, 0, 3, 2, 4)

    qc = to_chunks(q) * (DK ** -0.5)
    kc, vc, gc = to_chunks(k), to_chunks(v), to_chunks(log_a)
    causal = jnp.tril(jnp.ones((C, C), dtype=bool))[:, :, None]

    def step(state, inp):
        qi, ki, vi, gi = inp
        G = jnp.cumsum(gi, axis=-2)
        diff = G[..., :, None, :] - G[..., None, :, :]
        decay = jnp.exp(jnp.where(causal, diff, -jnp.inf))
        scores = jnp.einsum('bhtd,bhtsd,bhsd->bhts', qi, decay, ki)
        o = (jnp.einsum('bhts,bhsv->bhtv', scores, vi)
             + jnp.einsum('bhtd,bhdv->bhtv', qi * jnp.exp(G), state))
        G_last = G[..., -1:, :]
        state = (jnp.exp(G[..., -1, :])[..., None] * state
                 + jnp.einsum('bhsd,bhsv->bhdv', ki * jnp.exp(G_last - G), vi))
        return state, o

    state0 = jnp.zeros((B, H, DK, DV), jnp.float32)
    _, o = lax.scan(step, state0, (qc, kc, vc, gc))
    return o.transpose(1, 0, 3, 2, 4).reshape(B, S, H, DV).astype(v.dtype)


def _spatial_gating(u, v, ln_g, ln_b, w_s, b_s):
    B, S, _ = v.shape
    N = S // SG_CHUNK
    vf = v.astype(jnp.float32).reshape(B, S, SG_GROUPS, SG_GROUP_DIM)
    mu = jnp.mean(vf, axis=-1, keepdims=True)
    var = jnp.mean(jnp.square(vf - mu), axis=-1, keepdims=True)
    vn = (vf - mu) * lax.rsqrt(var + EPS)
    vn = vn * ln_g.astype(jnp.float32).reshape(SG_GROUPS, SG_GROUP_DIM) + ln_b.astype(jnp.float32).reshape(SG_GROUPS, SG_GROUP_DIM)
    vn = vn.reshape(B, N, SG_CHUNK, SG_GROUPS, SG_GROUP_DIM)
    w = w_s.astype(jnp.float32) * jnp.tril(jnp.ones((SG_CHUNK, SG_CHUNK), jnp.float32))[None]
    mixed = jnp.einsum('gts,bnsgc->bntgc', w, vn) + b_s.astype(jnp.float32).T[None, None, :, :, None]
    out = u.astype(jnp.float32).reshape(B, N, SG_CHUNK, SG_GROUPS, SG_GROUP_DIM) * mixed
    return out.reshape(B, S, SG_WIDTH).astype(u.dtype)


def setup_inputs(seed: int = 0) -> dict:
    key = jax.random.key(seed)
    ks = jax.random.split(key, 16)
    f32 = jnp.float32
    nrm = lambda k, shp, s: jax.random.normal(k, shp, f32) * s
    return {
        "x": jax.random.normal(ks[0], (BATCH, SEQ, D_MODEL), f32),
        "c": jax.random.normal(ks[1], (BATCH, D_MODEL), f32),
        "norm_g": 1.0 + nrm(ks[2], (DEPTH, D_MODEL), 0.02),
        "w_ada": nrm(ks[3], (DEPTH, D_MODEL, 3 * D_MODEL), 0.5 * D_MODEL ** -0.5),
        "b_ada": nrm(ks[4], (DEPTH, 3 * D_MODEL), 0.02),
        "w_in": nrm(ks[5], (DEPTH, D_MODEL, IN_WIDTH), D_MODEL ** -0.5),
        "w_alpha2": nrm(ks[6], (DEPTH, GATE_RANK, GLA_KW), GATE_RANK ** -0.5),
        "b_alpha": nrm(ks[7], (DEPTH, GLA_KW), 0.1),
        "gla_norm_g": 1.0 + nrm(ks[8], (DEPTH, GLA_WIDTH), 0.02),
        "sg_ln_g": 1.0 + nrm(ks[9], (DEPTH, SG_WIDTH), 0.02),
        "sg_ln_b": nrm(ks[10], (DEPTH, SG_WIDTH), 0.02),
        "w_spatial": nrm(ks[11], (DEPTH, SG_GROUPS, SG_CHUNK, SG_CHUNK), 0.5 * SG_CHUNK ** -0.5),
        "b_spatial": 1.0 + nrm(ks[12], (DEPTH, SG_GROUPS, SG_CHUNK), 0.01),
        "w_out": nrm(ks[13], (DEPTH, D_MIX, D_MODEL), D_MIX ** -0.5),
        "final_g": 1.0 + nrm(ks[14], (D_MODEL,), 0.02),
    }


def reference(x, c, norm_g, w_ada, b_ada, w_in, w_alpha2, b_alpha, gla_norm_g,
              sg_ln_g, sg_ln_b, w_spatial, b_spatial, w_out, final_g):
    B, S, _ = x.shape
    split_pts = list(np.cumsum(IN_SPLIT)[:-1])
    c_act = jax.nn.silu(c)
    for l in range(DEPTH):
        mod = c_act @ w_ada[l] + b_ada[l]
        shift, scale, gate = jnp.split(mod, 3, axis=-1)
        h = _rmsnorm(x, norm_g[l]) * (1.0 + scale[:, None, :]) + shift[:, None, :]
        p = h @ w_in[l]
        q, k, v_g, a_lr, r_g, u_s, v_s, r_s = jnp.split(p, split_pts, axis=-1)

        z_a = (a_lr @ w_alpha2[l] + b_alpha[l]).astype(jnp.float32)
        log_a = jax.nn.log_sigmoid(z_a) / GATE_TAU
        o_gla = _gla(q.reshape(B, S, GLA_HEADS, GLA_DK),
                     k.reshape(B, S, GLA_HEADS, GLA_DK),
                     v_g.reshape(B, S, GLA_HEADS, GLA_DV),
                     log_a.reshape(B, S, GLA_HEADS, GLA_DK))
        o_gla = _rmsnorm(o_gla, gla_norm_g[l].reshape(GLA_HEADS, GLA_DV)).reshape(B, S, GLA_WIDTH)
        o_gla = o_gla * jax.nn.silu(r_g)

        o_sg = _spatial_gating(jax.nn.gelu(u_s, approximate=False), jax.nn.gelu(v_s, approximate=False),
                               sg_ln_g[l], sg_ln_b[l], w_spatial[l], b_spatial[l])
        o_sg = o_sg * jax.nn.silu(r_s)

        y = jnp.concatenate([o_gla, o_sg], axis=-1) @ w_out[l]
        x = x + gate[:, None, :] * y
    return _rmsnorm(x, final_g)
```

```cpp
#include <hip/hip_runtime.h>
#include <hip/hip_cooperative_groups.h>
#include <cstdio>
namespace cg = cooperative_groups;

typedef unsigned short bf16_t;
constexpr int NB = 32, SEQ = 2048, DM = 1024, NL = 4, NT = NB * SEQ;
constexpr int INW = 3088;
constexpr int PW = 2560;
constexpr int NWT = 3072;
constexpr float EPS = 1e-6f;
constexpr int LDS_BYTES = 147456, MISC_OFF = LDS_BYTES - 256;
constexpr size_t XCH_BYTES = 256 * 4 * 256 * 4;
constexpr size_t CTL_BYTES = 98304;

typedef float ntf4 __attribute__((ext_vector_type(4)));
typedef unsigned ntu2 __attribute__((ext_vector_type(2)));
typedef unsigned ntu4 __attribute__((ext_vector_type(4)));
#define LDNT(p) __builtin_nontemporal_load(p)
__device__ __forceinline__ float bf2f(bf16_t v) { return __uint_as_float(((unsigned)v) << 16); }
__device__ __forceinline__ bf16_t f2bf(float f) { unsigned u = __float_as_uint(f); u += 0x7FFFu + ((u >> 16) & 1u); return (bf16_t)(u >> 16); }
__device__ __forceinline__ float silu_f(float v) { return v / (1.f + expf(-v)); }
__device__ __forceinline__ float gelu_f(float v) { return 0.5f * v * (1.f + erff(v * 0.70710678118654752f)); }
template <int CTRL> __device__ __forceinline__ float dpp_mov(float v) { return __int_as_float(__builtin_amdgcn_update_dpp(0, __float_as_int(v), CTRL, 0xf, 0xf, true)); }
__device__ __forceinline__ float red4(float v) { v += dpp_mov<0xB1>(v); v += dpp_mov<0x4E>(v); return v; }
__device__ __forceinline__ float red8(float v) { v = red4(v); v += dpp_mov<0x141>(v); return v; }
__device__ __forceinline__ float red16(float v) { v = red8(v); v += dpp_mov<0x140>(v); return v; }
__device__ __forceinline__ float wave_sum(float v) {
    v = red16(v);
    const float a = __int_as_float(__builtin_amdgcn_readlane(__float_as_int(v), 0)), b = __int_as_float(__builtin_amdgcn_readlane(__float_as_int(v), 16));
    const float c = __int_as_float(__builtin_amdgcn_readlane(__float_as_int(v), 32)), d = __int_as_float(__builtin_amdgcn_readlane(__float_as_int(v), 48));
    return (a + b) + (c + d);
}

namespace pg8 {
#define PG8_LAS __attribute__((address_space(3)))
typedef unsigned short bf16_t;
typedef short bf16x8 __attribute__((ext_vector_type(8)));
typedef float f32x4 __attribute__((ext_vector_type(4)));
typedef unsigned u32x4 __attribute__((ext_vector_type(4)));
constexpr int BM = 256, BK = 64, HALF = 128, HTB = HALF * BK * 2  , STAGE_BYTES = 8 * HTB, NXCD = 8, WGM = 8;

__host__ __device__ __forceinline__ int lds_byte(int r, int c) { const int st = (r >> 4) * 2 + (c >> 5), rr = r & 15, cc = c & 31, ob = rr * 64 + cc * 2; return st * 1024 + (ob ^ (((ob >> 9) & 1) << 5)); }
__host__ __device__ __forceinline__ void stage_rc(int b, int& R, int& C) { const int st = b / 1024, sb = b % 1024, swz = sb ^ (((sb >> 9) & 1) << 5); R = (st >> 1) * 16 + swz / 64; C = (st & 1) * 32 + (swz % 64) / 2; }
__host__ __device__ __forceinline__ int perm32(int rho) { const int n = rho >> 4, i = rho & 15; return 8 * (i >> 2) + 4 * n + (i & 3); }

struct Unit { int pm, pn; };
struct Gemm { const bf16_t* A; const bf16_t* Bt; int M, N, K; };

struct StaticOrder {
    int nM, nN, nwg, G, c;
    __host__ __device__ void init(int M, int N, int G_, int c_) { nM = M / BM; nN = N / BM; nwg = nM * nN; G = G_; c = c_; }
    __host__ __device__ bool next(int i, Unit& u) const {
        const long L = (long)i * G + c; if (L >= nwg) return false;
        int wgid = (int)L; { const int q = nwg / NXCD, r = nwg % NXCD, xcd = wgid % NXCD, off = wgid / NXCD; wgid = (xcd < r ? xcd * (q + 1) : r * (q + 1) + (xcd - r) * q) + off; }
        const int nig = WGM * nN, gid = wgid / nig, fm = gid * WGM, gsz = (nM - fm) < WGM ? (nM - fm) : WGM;
        u.pm = fm + ((wgid % nig) % gsz); u.pn = (wgid % nig) / gsz; return true;
    }
    __device__ __forceinline__ void a_ready(const Unit&) const {}
    __device__ __forceinline__ void done(const Unit&) const {}
};

struct PanelOrder {
    int pm0, n, pn; unsigned* cnt0; unsigned need; int skip_at, skip;
    __device__ __forceinline__ bool next(int i, Unit& u) const { if (i >= n) return false; u.pm = pm0 + i + (i >= skip_at ? skip : 0); u.pn = pn; return true; }
    __device__ __forceinline__ void a_ready(const Unit& u) const {
        if (threadIdx.x < 64) {
            unsigned* c = cnt0 + 16 * (u.pm - pm0); unsigned sp = 0u;
            while ((unsigned)__builtin_amdgcn_readfirstlane((int)__hip_atomic_load(c, __ATOMIC_RELAXED, __HIP_MEMORY_SCOPE_AGENT)) < need) { __builtin_amdgcn_s_sleep(2); if (++sp > (1u << 21)) break; }
            __builtin_amdgcn_fence(__ATOMIC_ACQUIRE, "agent");
            asm volatile("s_waitcnt vmcnt(0)" ::: "memory");
        }
        asm volatile("" ::: "memory"); __builtin_amdgcn_s_barrier(); asm volatile("" ::: "memory");
    }
    __device__ __forceinline__ void done(const Unit&) const {}
};

__device__ __forceinline__ unsigned cvt_pk_bf16(float lo, float hi) { unsigned r; asm volatile("v_cvt_pk_bf16_f32 %0, %1, %2" : "=v"(r) : "v"(lo), "v"(hi)); return r; }
typedef float f32x2 __attribute__((ext_vector_type(2)));
__device__ __forceinline__ f32x2 gelu_den(f32x2 v) {
    const f32x2 x2 = v * v;
    f32x2 p = x2 * (-3.228972053e-06f) + 8.823774386e-05f; p = p * x2 + 3.602777123e-04f; p = p * x2 + (-1.052266981e-01f); p = p * x2 + (-2.302045381e+00f);
    const f32x2 w = p * v;
    f32x2 e; e.x = __builtin_amdgcn_exp2f(w.x); e.y = __builtin_amdgcn_exp2f(w.y);
    return e + 1.0f;
}
__device__ __forceinline__ f32x2 gelu_pk(f32x2 v) {
    const f32x2 d = gelu_den(v);
    f32x2 o; o.x = v.x * __builtin_amdgcn_rcpf(d.x); o.y = v.y * __builtin_amdgcn_rcpf(d.y); return o;
}

__device__ __forceinline__ float silu_fast(float v) { return v * __builtin_amdgcn_rcpf(1.0f + __builtin_amdgcn_exp2f(-1.4426950408889634f * v)); }
__device__ __forceinline__ f32x2 gelu_silu(f32x2 u, f32x2 r) {
    const f32x2 du = gelu_den(u), s = r * (-1.4426950408889634f);
    f32x2 er; er.x = __builtin_amdgcn_exp2f(s.x); er.y = __builtin_amdgcn_exp2f(s.y);
    const f32x2 dd = du * (er + 1.0f), n = u * r;
    f32x2 o; o.x = n.x * __builtin_amdgcn_rcpf(dd.x); o.y = n.y * __builtin_amdgcn_rcpf(dd.y); return o;
}
constexpr int PWc = 2560;
__host__ __device__ __forceinline__ int slot_tile(int slot) { return (int)((0x975486ba3210ull >> (4 * slot)) & 15ull); }
struct EpiInprojMF {
    static constexpr bool PERM = true, AFTER_DRAIN = false;
    bf16_t* P;
    template <int ACT> __device__ __forceinline__ void store_tile(const f32x4 (&acc)[2][2][4][2], bf16_t* base) const {
#pragma unroll
        for (int ai = 0; ai < 2; ++ai)
#pragma unroll
            for (int m = 0; m < 4; ++m) { bf16_t* rowp = base + (size_t)(ai * HALF + m * 16) * PWc;
#pragma unroll
                for (int bj = 0; bj < 2; ++bj) { f32x4 v0 = acc[ai][bj][m][0], v1 = acc[ai][bj][m][1];
                    if (ACT == 0) { v0 = v0 * 0.125f; v1 = v1 * 0.125f; }
                    if (ACT == 2) {
#pragma unroll
                        for (int j = 0; j < 4; ++j) { v0[j] = silu_fast(v0[j]); v1[j] = silu_fast(v1[j]); } }
                    if (ACT == 3) { f32x2 a = gelu_pk((f32x2){v0[0], v0[1]}), b = gelu_pk((f32x2){v0[2], v0[3]}), c = gelu_pk((f32x2){v1[0], v1[1]}), d = gelu_pk((f32x2){v1[2], v1[3]});
                        v0 = (f32x4){a.x, a.y, b.x, b.y}; v1 = (f32x4){c.x, c.y, d.x, d.y}; }
                    u32x4 w; w.x = cvt_pk_bf16(v0[0], v0[1]); w.y = cvt_pk_bf16(v0[2], v0[3]); w.z = cvt_pk_bf16(v1[0], v1[1]); w.w = cvt_pk_bf16(v1[2], v1[3]);
                    *(u32x4*)(rowp + bj * HALF) = w; } }
    }
    __device__ __forceinline__ void store_ur(const f32x4 (&acc)[2][2][4][2], bf16_t* base) const {
#pragma unroll
        for (int ai = 0; ai < 2; ++ai)
#pragma unroll
            for (int m = 0; m < 4; ++m) { bf16_t* rowp = base + (size_t)(ai * HALF + m * 16) * PWc;
                const f32x4 u0 = acc[ai][0][m][0], u1 = acc[ai][0][m][1], r0 = acc[ai][1][m][0], r1 = acc[ai][1][m][1];
                const f32x2 a = gelu_silu((f32x2){u0[0], u0[1]}, (f32x2){r0[0], r0[1]}), b = gelu_silu((f32x2){u0[2], u0[3]}, (f32x2){r0[2], r0[3]});
                const f32x2 c = gelu_silu((f32x2){u1[0], u1[1]}, (f32x2){r1[0], r1[1]}), d = gelu_silu((f32x2){u1[2], u1[3]}, (f32x2){r1[2], r1[3]});
                u32x4 w;
                w.x = cvt_pk_bf16(a.x, a.y); w.y = cvt_pk_bf16(b.x, b.y); w.z = cvt_pk_bf16(c.x, c.y); w.w = cvt_pk_bf16(d.x, d.y);
                *(u32x4*)rowp = w; }
    }
    __device__ __forceinline__ void operator()(const f32x4 (&acc)[2][2][4][2], const Unit& u, int wr, int wc, int fr, int fq) const {
        const int row0 = u.pm * BM + wr * 64 + fr, pn = slot_tile(u.pn);
        const int colb = (pn < 6) ? pn * BM : ((pn < 10) ? 1536 + 128 * (pn - 6) : 2048 + BM * (pn - 10));
        bf16_t* base = P + (size_t)row0 * PWc + colb + wc * 32 + 8 * fq;
        if (pn == 0) store_tile<0>(acc, base);
        else if (pn < 4) store_tile<1>(acc, base);
        else if (pn < 6) store_tile<2>(acc, base);
        else if (pn < 10) store_ur(acc, base);
        else store_tile<3>(acc, base);
    }
};
template <bool F32IN> struct EpiOutprojRes {
    static constexpr bool PERM = true, AFTER_DRAIN = false;
    const float* xin32; const bf16_t* xin16; bf16_t* xout; const float* gate;
    __device__ __forceinline__ void operator()(const f32x4 (&acc)[2][2][4][2], const Unit& u, int wr, int wc, int fr, int fq) const {
        const int b = u.pm >> 3;
        const size_t off0 = (size_t)(u.pm * BM + wr * 64 + fr) * 1024 + u.pn * BM + wc * 32 + 8 * fq;
        f32x4 gv[2][2];
#pragma unroll
        for (int bj = 0; bj < 2; ++bj)
#pragma unroll
            for (int n = 0; n < 2; ++n) gv[bj][n] = *(const f32x4*)(gate + (size_t)b * 3072 + u.pn * BM + wc * 32 + 8 * fq + bj * HALF + 4 * n);
        if constexpr (!F32IN) {
            u32x4 xi[2][4][2];
#pragma unroll
            for (int ai = 0; ai < 2; ++ai)
#pragma unroll
                for (int m = 0; m < 4; ++m)
#pragma unroll
                    for (int bj = 0; bj < 2; ++bj) xi[ai][m][bj] = *(const u32x4*)(xin16 + off0 + (size_t)(ai * HALF + m * 16) * 1024 + bj * HALF);
#pragma unroll
            for (int ai = 0; ai < 2; ++ai)
#pragma unroll
                for (int m = 0; m < 4; ++m)
#pragma unroll
                    for (int bj = 0; bj < 2; ++bj) { const u32x4 x = xi[ai][m][bj]; const f32x4 a0 = acc[ai][bj][m][0], a1 = acc[ai][bj][m][1], g0 = gv[bj][0], g1 = gv[bj][1];
                        u32x4 w;
                        w.x = cvt_pk_bf16(__uint_as_float(x.x << 16) + g0[0] * a0[0], __uint_as_float(x.x & 0xffff0000u) + g0[1] * a0[1]);
                        w.y = cvt_pk_bf16(__uint_as_float(x.y << 16) + g0[2] * a0[2], __uint_as_float(x.y & 0xffff0000u) + g0[3] * a0[3]);
                        w.z = cvt_pk_bf16(__uint_as_float(x.z << 16) + g1[0] * a1[0], __uint_as_float(x.z & 0xffff0000u) + g1[1] * a1[1]);
                        w.w = cvt_pk_bf16(__uint_as_float(x.w << 16) + g1[2] * a1[2], __uint_as_float(x.w & 0xffff0000u) + g1[3] * a1[3]);
                        *(u32x4*)(xout + off0 + (size_t)(ai * HALF + m * 16) * 1024 + bj * HALF) = w; }
        } else {
#pragma unroll
            for (int ai = 0; ai < 2; ++ai) {
                f32x4 xi[4][2][2];
#pragma unroll
                for (int m = 0; m < 4; ++m)
#pragma unroll
                    for (int bj = 0; bj < 2; ++bj)
#pragma unroll
                        for (int n = 0; n < 2; ++n) xi[m][bj][n] = *(const f32x4*)(xin32 + off0 + (size_t)(ai * HALF + m * 16) * 1024 + bj * HALF + 4 * n);
#pragma unroll
                for (int m = 0; m < 4; ++m)
#pragma unroll
                    for (int bj = 0; bj < 2; ++bj) { const f32x4 v0 = xi[m][bj][0] + gv[bj][0] * acc[ai][bj][m][0], v1 = xi[m][bj][1] + gv[bj][1] * acc[ai][bj][m][1];
                        u32x4 w; w.x = cvt_pk_bf16(v0[0], v0[1]); w.y = cvt_pk_bf16(v0[2], v0[3]); w.z = cvt_pk_bf16(v1[0], v1[1]); w.w = cvt_pk_bf16(v1[2], v1[3]);
                        *(u32x4*)(xout + off0 + (size_t)(ai * HALF + m * 16) * 1024 + bj * HALF) = w; }
            }
        }
    }
};

struct EpiOutprojFinal {
    static constexpr bool PERM = true, AFTER_DRAIN = false;
    const bf16_t* xin16; float* out; const float* gate; const float* fg;
    float* xch;
    PG8_LAS float* sl;
    __device__ __forceinline__ void operator()(f32x4 (&acc)[2][2][4][2], const Unit& u, int wr, int wc, int fr, int fq) const {
        const int b = u.pm >> 3;
        const int colu = u.pn * BM + wc * 32;
        const size_t rowu = (size_t)(u.pm * BM + wr * 64) * 1024 + colu;
        const unsigned lo = (unsigned)(fr * 1024 + 8 * fq) * 2u;
        const unsigned lc = (unsigned)(8 * fq) * 4u;
#define EF_ROW(arr, ai, m, bj) ((arr) + rowu + (size_t)((ai) * HALF + (m) * 16) * 1024 + (bj) * HALF)
        f32x4 gv[2][2];
#pragma unroll
        for (int bj = 0; bj < 2; ++bj)
#pragma unroll
            for (int n = 0; n < 2; ++n) gv[bj][n] = *(const f32x4*)((const char*)(gate + (size_t)b * 3072 + colu + bj * HALF + 4 * n) + lc);
        u32x4 xi[2][4][2];
#pragma unroll
        for (int ai = 0; ai < 2; ++ai)
#pragma unroll
            for (int m = 0; m < 4; ++m)
#pragma unroll
                for (int bj = 0; bj < 2; ++bj) xi[ai][m][bj] = *(const u32x4*)((const char*)EF_ROW(xin16, ai, m, bj) + lo);
        float ss[2][4];
#pragma unroll
        for (int ai = 0; ai < 2; ++ai)
#pragma unroll
            for (int m = 0; m < 4; ++m) { float s = 0.f;
#pragma unroll
                for (int bj = 0; bj < 2; ++bj) { const u32x4 x = xi[ai][m][bj]; const f32x4 a0 = acc[ai][bj][m][0], a1 = acc[ai][bj][m][1], g0 = gv[bj][0], g1 = gv[bj][1];
                    f32x4 y0, y1;
                    y0[0] = __uint_as_float(x.x << 16) + g0[0] * a0[0]; y0[1] = __uint_as_float(x.x & 0xffff0000u) + g0[1] * a0[1];
                    y0[2] = __uint_as_float(x.y << 16) + g0[2] * a0[2]; y0[3] = __uint_as_float(x.y & 0xffff0000u) + g0[3] * a0[3];
                    y1[0] = __uint_as_float(x.z << 16) + g1[0] * a1[0]; y1[1] = __uint_as_float(x.z & 0xffff0000u) + g1[1] * a1[1];
                    y1[2] = __uint_as_float(x.w << 16) + g1[2] * a1[2]; y1[3] = __uint_as_float(x.w & 0xffff0000u) + g1[3] * a1[3];
                    acc[ai][bj][m][0] = y0; acc[ai][bj][m][1] = y1;
                    s += (y0[0] * y0[0] + y0[1] * y0[1]) + (y0[2] * y0[2] + y0[3] * y0[3]) + (y1[0] * y1[0] + y1[1] * y1[1]) + (y1[2] * y1[2] + y1[3] * y1[3]); }
                ss[ai][m] = s; }
#pragma unroll
        for (int ai = 0; ai < 2; ++ai)
#pragma unroll
            for (int m = 0; m < 4; ++m) { float s = ss[ai][m]; s += __shfl_xor(s, 16); s += __shfl_xor(s, 32); if (fq == 0) sl[wc * 256 + ai * HALF + wr * 64 + m * 16 + fr] = s; }
        f32x4 fv[2][2];
#pragma unroll
        for (int bj = 0; bj < 2; ++bj)
#pragma unroll
            for (int n = 0; n < 2; ++n) fv[bj][n] = *(const f32x4*)((const char*)(fg + colu + bj * HALF + 4 * n) + lc);
        asm volatile("s_waitcnt lgkmcnt(0)" ::: "memory"); __builtin_amdgcn_s_barrier(); asm volatile("" ::: "memory");
        const unsigned t = (unsigned)((wr * 4 + wc) * 64 + fq * 16 + fr);
        if (wr == 0) {
            const float S = ((sl[t] + sl[256 + t]) + (sl[512 + t] + sl[768 + t])) + 1e-30f;
            float* xp = xch + (size_t)u.pm * 1024;
            __hip_atomic_store((xp + u.pn * 256) + t, S, __ATOMIC_RELAXED, __HIP_MEMORY_SCOPE_AGENT);
            const int q1 = (u.pn + 1) & 3, q2 = (u.pn + 2) & 3, q3 = (u.pn + 3) & 3;
            float s1, s2, s3; unsigned sp = 0u;
            for (;;) {
                s1 = __hip_atomic_load((xp + q1 * 256) + t, __ATOMIC_RELAXED, __HIP_MEMORY_SCOPE_AGENT);
                s2 = __hip_atomic_load((xp + q2 * 256) + t, __ATOMIC_RELAXED, __HIP_MEMORY_SCOPE_AGENT);
                s3 = __hip_atomic_load((xp + q3 * 256) + t, __ATOMIC_RELAXED, __HIP_MEMORY_SCOPE_AGENT);
                const bool ok = (s1 > 0.f) && (s2 > 0.f) && (s3 > 0.f);
                if (__builtin_amdgcn_ballot_w64(!ok) == 0ull) break;
                __builtin_amdgcn_s_sleep(1); if (++sp > (1u << 20)) break;
            }
            sl[1024 + t] = __builtin_amdgcn_rsqf(((S + s1) + (s2 + s3)) * (1.0f / 1024.0f) + 1e-6f);
        }
        asm volatile("s_waitcnt lgkmcnt(0)" ::: "memory"); __builtin_amdgcn_s_barrier(); asm volatile("" ::: "memory");
        const unsigned lo4 = (unsigned)(fr * 1024 + 8 * fq) * 4u;
#pragma unroll
        for (int ai = 0; ai < 2; ++ai)
#pragma unroll
            for (int m = 0; m < 4; ++m) { const float r = sl[1024 + ai * HALF + wr * 64 + m * 16 + fr];
#pragma unroll
                for (int bj = 0; bj < 2; ++bj) { float* op = (float*)((char*)EF_ROW(out, ai, m, bj) + lo4);
                    *(f32x4*)op = acc[ai][bj][m][0] * r * fv[bj][0]; *(f32x4*)(op + 4) = acc[ai][bj][m][1] * r * fv[bj][1]; } }
#undef EF_ROW
    }
};

template <class Epi, class Sched, bool ALIGN_EPI = false, bool SP2 = false>
__device__ __forceinline__ void gemm_phase(PG8_LAS unsigned char* lds, const Gemm g, const Sched& S, const Epi& E, const int tid) {
    const int wid = __builtin_amdgcn_readfirstlane(tid >> 6), lane = tid & 63, wr = wid >> 2, wc = wid & 3, fr = lane & 15, fq = lane >> 4;
    const int K = g.K, nt = K / BK;
    unsigned voffA[2], voffB[2];
#pragma unroll
    for (int i = 0; i < 2; ++i) { int R, C; stage_rc(tid * 16 + i * 8192, R, C); const int Rb = Epi::PERM ? ((R & ~31) + perm32(R & 31)) : R;
        voffA[i] = (unsigned)(R * K + C) * 2u; voffB[i] = (unsigned)(Rb * K + C) * 2u; }
    const size_t kstep = (size_t)(BK * 2);
    const size_t hstep = (size_t)HALF * K * 2;
    const size_t tstep = 2 * hstep;
    const unsigned ldsw = (unsigned)wid * 1024u;
#define PG8_SA(b, h) (((b) * 2 + (h)) * HTB)
#define PG8_SB(b, h) ((4 + (b) * 2 + (h)) * HTB)
#define PG8_STAGE(bufoff, gbase, voff) do { _Pragma("unroll") for (int _i = 0; _i < 2; ++_i) \
        __builtin_amdgcn_global_load_lds((const unsigned*)((const char*)(gbase) + (voff)[_i]), (PG8_LAS unsigned*)(lds + (bufoff) + ldsw + _i * 8192), 16, 0, 0); } while (0)
#define PG8_LDA(dst, b, h) do { _Pragma("unroll") for (int m = 0; m < 4; ++m) _Pragma("unroll") for (int k = 0; k < 2; ++k) dst[m][k] = *(const PG8_LAS bf16x8*)(lds + PG8_SA(b, h) + aoff + m * 2048 + k * 1024); } while (0)
#define PG8_LDB(dst, b, h) do { _Pragma("unroll") for (int n = 0; n < 2; ++n) _Pragma("unroll") for (int k = 0; k < 2; ++k) dst[n][k] = *(const PG8_LAS bf16x8*)(lds + PG8_SB(b, h) + boff + n * 2048 + k * 1024); } while (0)
#define PG8_MMA(ai, bj, At, Bt) do { __builtin_amdgcn_s_setprio(1); _Pragma("unroll") for (int m = 0; m < 4; ++m) _Pragma("unroll") for (int n = 0; n < 2; ++n) _Pragma("unroll") for (int k = 0; k < 2; ++k) \
        acc[ai][bj][m][n] = __builtin_amdgcn_mfma_f32_16x16x32_bf16(Bt[n][k], At[m][k], acc[ai][bj][m][n], 0, 0, 0); __builtin_amdgcn_s_setprio(0); } while (0)
#define PG8_MMAZ(ai, bj, At, Bt) do { __builtin_amdgcn_s_setprio(1); _Pragma("unroll") for (int m = 0; m < 4; ++m) _Pragma("unroll") for (int n = 0; n < 2; ++n) { acc[ai][bj][m][n] = __builtin_amdgcn_mfma_f32_16x16x32_bf16(Bt[n][0], At[m][0], (f32x4){0.f, 0.f, 0.f, 0.f}, 0, 0, 0); \
        acc[ai][bj][m][n] = __builtin_amdgcn_mfma_f32_16x16x32_bf16(Bt[n][1], At[m][1], acc[ai][bj][m][n], 0, 0, 0); } __builtin_amdgcn_s_setprio(0); } while (0)
#define PG8_WAIT_V(n) asm volatile("s_waitcnt vmcnt(" #n ")" ::: "memory")
#define PG8_WAIT_L(n) asm volatile("s_waitcnt lgkmcnt(" #n ")" ::: "memory")
#define PG8_BAR __builtin_amdgcn_s_barrier()
#define PG8_SCHED __builtin_amdgcn_sched_barrier(0)
    Unit cur, nxt; int ui = 0;
    if (!S.next(0, cur)) return;
    f32x4 acc[2][2][4][2];
    if constexpr (!SP2) {
#pragma unroll
    for (int a = 0; a < 2; ++a)
#pragma unroll
        for (int b = 0; b < 2; ++b)
#pragma unroll
            for (int m = 0; m < 4; ++m)
#pragma unroll
                for (int n = 0; n < 2; ++n) acc[a][b][m][n] = (f32x4){0.f, 0.f, 0.f, 0.f};
    }
    bf16x8 At[4][2], B0[2][2], B1[2][2];
    const char* cA = (const char*)g.A + (size_t)cur.pm * tstep; const char* cB = (const char*)g.Bt + (size_t)cur.pn * tstep;
    S.a_ready(cur);
    if constexpr (SP2) {
        PG8_STAGE(PG8_SB(0, 0), cB, voffB); PG8_STAGE(PG8_SB(0, 1), cB + hstep, voffB); PG8_STAGE(PG8_SA(0, 0), cA, voffA); PG8_STAGE(PG8_SA(0, 1), cA + hstep, voffA);
        if (wr == 1) PG8_BAR;
        PG8_WAIT_V(2); PG8_BAR;
        PG8_STAGE(PG8_SB(1, 0), cB + kstep, voffB); PG8_STAGE(PG8_SA(1, 0), cA + kstep, voffA); PG8_STAGE(PG8_SB(1, 1), cB + hstep + kstep, voffB);
        PG8_WAIT_V(6); PG8_BAR;
    } else {
        PG8_STAGE(PG8_SB(0, 0), cB, voffB); PG8_STAGE(PG8_SA(0, 0), cA, voffA); PG8_STAGE(PG8_SB(0, 1), cB + hstep, voffB); PG8_STAGE(PG8_SA(0, 1), cA + hstep, voffA);
        if (wr == 1) PG8_BAR;
        PG8_WAIT_V(4); PG8_BAR;
        PG8_STAGE(PG8_SB(1, 0), cB + kstep, voffB); PG8_STAGE(PG8_SA(1, 0), cA + kstep, voffA); PG8_STAGE(PG8_SB(1, 1), cB + hstep + kstep, voffB);
        PG8_WAIT_V(6); PG8_BAR;
    }
    for (;;) {
        const bool has_next = S.next(ui + 1, nxt);
        const char* nA = has_next ? (const char*)g.A + (size_t)nxt.pm * tstep : cA; const char* nB = has_next ? (const char*)g.Bt + (size_t)nxt.pn * tstep : cB;
        for (int t = 0; t < nt; t += 2) {
            const bool last = (t == nt - 2);
            int lq_ = lane; asm volatile("" : "+v"(lq_));
            const int aoff = lds_byte(wr * 64 + (lq_ & 15), (lq_ >> 4) * 8), boff = lds_byte(wc * 32 + (lq_ & 15), (lq_ >> 4) * 8);
            const char* a1 = cA + (size_t)(t + 1) * kstep;
            const char* a2 = last ? nA : cA + (size_t)(t + 2) * kstep; const char* b2 = last ? nB : cB + (size_t)(t + 2) * kstep;
            const char* a3 = a2 + kstep; const char* b3 = b2 + kstep;
            if (last && has_next) S.a_ready(nxt);
            if constexpr (SP2) {
            PG8_LDB(B0, 0, 0); PG8_LDB(B1, 0, 1); PG8_SCHED; PG8_LDA(At, 0, 0); PG8_STAGE(PG8_SA(1, 1), a1 + hstep, voffA);
            PG8_WAIT_V(8); PG8_WAIT_L(0); PG8_BAR; if (t == 0) { PG8_MMAZ(0, 0, At, B0); PG8_MMAZ(0, 1, At, B1); } else { PG8_MMA(0, 0, At, B0); PG8_MMA(0, 1, At, B1); } PG8_BAR; PG8_SCHED;
            PG8_LDA(At, 0, 1); PG8_STAGE(PG8_SB(0, 0), b2, voffB); PG8_STAGE(PG8_SB(0, 1), b2 + hstep, voffB); PG8_STAGE(PG8_SA(0, 0), a2, voffA);
            PG8_WAIT_V(8); PG8_WAIT_L(0); PG8_BAR; if (t == 0) { PG8_MMAZ(1, 0, At, B0); PG8_MMAZ(1, 1, At, B1); } else { PG8_MMA(1, 0, At, B0); PG8_MMA(1, 1, At, B1); } PG8_BAR; PG8_SCHED;
            PG8_LDB(B0, 1, 0); PG8_LDB(B1, 1, 1); PG8_SCHED; PG8_LDA(At, 1, 0); PG8_STAGE(PG8_SA(0, 1), a2 + hstep, voffA);
            PG8_WAIT_V(8); PG8_WAIT_L(0); PG8_BAR; PG8_MMA(0, 0, At, B0); PG8_MMA(0, 1, At, B1); PG8_BAR; PG8_SCHED;
            PG8_LDA(At, 1, 1); PG8_STAGE(PG8_SB(1, 0), b3, voffB); PG8_STAGE(PG8_SB(1, 1), b3 + hstep, voffB); PG8_STAGE(PG8_SA(1, 0), a3, voffA);
            PG8_WAIT_V(8); PG8_WAIT_L(0); PG8_BAR; PG8_MMA(1, 0, At, B0); PG8_MMA(1, 1, At, B1); PG8_BAR; PG8_SCHED;
            } else {
            PG8_LDB(B0, 0, 0); PG8_SCHED; PG8_LDA(At, 0, 0); PG8_STAGE(PG8_SA(1, 1), a1 + hstep, voffA);
            PG8_WAIT_L(8); PG8_BAR; PG8_WAIT_L(0); PG8_MMA(0, 0, At, B0); PG8_BAR; PG8_SCHED;
            PG8_LDB(B1, 0, 1); PG8_STAGE(PG8_SB(0, 0), b2, voffB);
            PG8_BAR; PG8_WAIT_L(0); PG8_MMA(0, 1, At, B1); PG8_BAR;
            PG8_LDA(At, 0, 1); PG8_STAGE(PG8_SA(0, 0), a2, voffA);
            PG8_BAR; PG8_WAIT_L(0); PG8_MMA(1, 0, At, B0); PG8_BAR; PG8_SCHED;
            PG8_STAGE(PG8_SB(0, 1), b2 + hstep, voffB);
            PG8_WAIT_V(6); PG8_BAR; PG8_MMA(1, 1, At, B1); PG8_BAR;
            PG8_LDB(B0, 1, 0); PG8_SCHED; PG8_LDA(At, 1, 0); PG8_STAGE(PG8_SA(0, 1), a2 + hstep, voffA);
            PG8_WAIT_L(8); PG8_BAR; PG8_WAIT_L(0); PG8_MMA(0, 0, At, B0); PG8_BAR; PG8_SCHED;
            PG8_LDB(B1, 1, 1); PG8_STAGE(PG8_SB(1, 0), b3, voffB);
            PG8_BAR; PG8_WAIT_L(0); PG8_MMA(0, 1, At, B1); PG8_BAR;
            PG8_LDA(At, 1, 1); PG8_STAGE(PG8_SA(1, 0), a3, voffA);
            PG8_BAR; PG8_WAIT_L(0); PG8_MMA(1, 0, At, B0); PG8_BAR; PG8_SCHED;
            PG8_STAGE(PG8_SB(1, 1), b3 + hstep, voffB);
            PG8_WAIT_V(6); PG8_BAR; PG8_MMA(1, 1, At, B1); PG8_BAR;
            }
        }
        if constexpr (ALIGN_EPI) { if (wr == 0) PG8_BAR; }
        if constexpr (!Epi::AFTER_DRAIN) { E(acc, cur, wr, wc, fr, fq); S.done(cur); }
        if (!has_next) break;
        if constexpr (!SP2) {
#pragma unroll
        for (int a = 0; a < 2; ++a)
#pragma unroll
            for (int b = 0; b < 2; ++b)
#pragma unroll
                for (int m = 0; m < 4; ++m)
#pragma unroll
                    for (int n = 0; n < 2; ++n) acc[a][b][m][n] = (f32x4){0.f, 0.f, 0.f, 0.f};
        }
        cur = nxt; cA = nA; cB = nB; ++ui;
        if constexpr (ALIGN_EPI) { if (wr == 1) PG8_BAR; }
    }
    PG8_WAIT_V(0);
    if constexpr (!ALIGN_EPI) { if (wr == 0) PG8_BAR; }
    PG8_BAR;
    if constexpr (Epi::AFTER_DRAIN) { E.fused(acc, cur, wr, wc, fr, fq, lds, wid, lane); S.done(cur); }
#undef PG8_SA
#undef PG8_SB
#undef PG8_STAGE
#undef PG8_LDA
#undef PG8_LDB
#undef PG8_MMA
#undef PG8_MMAZ
#undef PG8_WAIT_V
#undef PG8_WAIT_L
#undef PG8_BAR
#undef PG8_SCHED
}
}

#define LAS __attribute__((address_space(3)))
#define XB_TMO      128
#define XB_XCNT(j)  (256  + 64 * (j))
#define XB_XSUB(j)  (1280 + 64 * (j))
#define XB_XGEN(j)  (2304 + 64 * (j))
#define XB_TOP      3328
#define XB_TOPGEN   3392
#define XCD_BAR_WORDS 3456
#define XB_SPIN_CAP (1u << 18)

__device__ __forceinline__ unsigned xb_ld(unsigned* p)              { return __hip_atomic_load(p, __ATOMIC_RELAXED, __HIP_MEMORY_SCOPE_AGENT); }
__device__ __forceinline__ unsigned xb_add(unsigned* p, unsigned v) { return __hip_atomic_fetch_add(p, v, __ATOMIC_RELAXED, __HIP_MEMORY_SCOPE_AGENT); }
__device__ __forceinline__ unsigned xb_xcc_id() { return (unsigned)__builtin_amdgcn_s_getreg((3 << 11) | 20) & 0xFu; }
#define XB_SPIN(cond, bar) do { unsigned _sp = 0; while (cond) { __builtin_amdgcn_s_sleep(1); \
    if ((++_sp & 255u) == 0u) { if (xb_ld(&(bar)[XB_TMO])) break; if (_sp > XB_SPIN_CAP) { atomicAdd(&(bar)[XB_TMO], 1u); break; } } } } while (0)

struct XcdBarrier {
    unsigned* bar; unsigned x;
    volatile LAS unsigned* st;
};

__device__ __forceinline__ XcdBarrier xcd_barrier_post(unsigned* bar, volatile LAS unsigned* st) {
    XcdBarrier b; b.bar = bar; b.x = xb_xcc_id(); b.st = st;
    if (threadIdx.x == 0) (void)xb_add(&bar[XB_XCNT(b.x)], 1u);
    return b;
}
__device__ __forceinline__ void xcd_barrier_complete(unsigned* bar, unsigned x, unsigned& nloc, unsigned& nx) {
    const unsigned G = gridDim.x * gridDim.y * gridDim.z;
    unsigned sum, cnt, mine, sp = 0u;
    for (;;) {
        sum = 0u; cnt = 0u; mine = 0u;
#pragma unroll
        for (unsigned j = 0; j < 16; ++j) { const unsigned c = xb_ld(&bar[XB_XCNT(j)]); sum += c; cnt += (c > 0u) ? 1u : 0u; mine = (j == x) ? c : mine; }
        if (sum == G) break;
        __builtin_amdgcn_s_sleep(1);
        if ((++sp & 255u) == 0u) { if (xb_ld(&bar[XB_TMO])) break; if (sp > XB_SPIN_CAP) { atomicAdd(&bar[XB_TMO], 1u); break; } }
    }
    nloc = mine > 0u ? mine : 1u; nx = cnt > 0u ? cnt : 1u;
}

__device__ __forceinline__ void xcd_barrier(const XcdBarrier& b) {
    asm volatile("s_waitcnt vmcnt(0)" ::: "memory");
    __syncthreads();
    if (threadIdx.x == 0) {
        unsigned* bar = b.bar;
        __builtin_amdgcn_s_waitcnt(0);
        unsigned nloc = b.st[0], nx = b.st[1];
        if (nloc == 0u) { xcd_barrier_complete(bar, b.x, nloc, nx); b.st[0] = nloc; b.st[1] = nx; }
        const unsigned old = xb_add(&bar[XB_XSUB(b.x)], 1u);
        const unsigned gen = old / nloc;
        if (old + 1u == (gen + 1u) * nloc) {
            __builtin_amdgcn_fence(__ATOMIC_RELEASE, "agent");
            asm volatile("s_waitcnt vmcnt(0)" ::: "memory");
            const unsigned og = xb_add(&bar[XB_TOP], 1u);
            const unsigned tg = og / nx;
            if (og + 1u == (tg + 1u) * nx) xb_add(&bar[XB_TOPGEN], 1u);
            else XB_SPIN(xb_ld(&bar[XB_TOPGEN]) == tg, bar);
            __builtin_amdgcn_fence(__ATOMIC_ACQUIRE, "agent");
            xb_add(&bar[XB_XGEN(b.x)], 1u);
            asm volatile("s_waitcnt vmcnt(0)" ::: "memory");
        } else {
            XB_SPIN(xb_ld(&bar[XB_XGEN(b.x)]) == gen, bar);
            __builtin_amdgcn_fence(__ATOMIC_ACQUIRE, "agent");
            asm volatile("s_waitcnt vmcnt(0)" ::: "memory");
        }
    }
    __syncthreads();
}


__device__ __forceinline__ unsigned* seam_cnt(unsigned* ctl, int l, int b, int j) { return ctl + 4096 + (((l * 32 + b) * 8 + j) * 16); }
typedef unsigned wtu32x4 __attribute__((ext_vector_type(4)));
__device__ __forceinline__ void store16_wt(void* base_uniform, unsigned byte_off, wtu32x4 v) {
    const __amdgpu_buffer_rsrc_t rs = __builtin_amdgcn_make_buffer_rsrc(base_uniform, 0, 0x7fffffff, 0x00020000);
    __builtin_amdgcn_raw_buffer_store_b128(v, rs, (int)byte_off, 0, 16);
}
__device__ __forceinline__ void publish_count_wt(unsigned* cnt, const int n, const int tid) {
    asm volatile("s_waitcnt vmcnt(0)" ::: "memory");
    __syncthreads();
    if (tid == 0) { for (int i = 0; i < n; ++i) (void)__hip_atomic_fetch_add(cnt + 16 * i, 1u, __ATOMIC_RELAXED, __HIP_MEMORY_SCOPE_AGENT); }
}

struct Params {
    const float *x, *c, *norm_g, *w_ada, *b_ada, *w_in, *w_alpha2, *b_alpha, *gla_norm_g, *sg_ln_g, *sg_ln_b, *w_spatial, *b_spatial, *w_out, *final_g;
    float* out;
    unsigned* ctl;
    float* mod;
    bf16_t* wt_in;
    bf16_t* wt_out;
    bf16_t* h;
    bf16_t* p;
    float* alr;
    bf16_t* cat;
    bf16_t* xb0;
    bf16_t* xb1;
};

#define GTID (bid * 512 + tid)
#define GSIZE ((int)(gridDim.x * 512))
__device__ __forceinline__ int opaque_v(int v) { asm volatile("" : "+v"(v)); return v; }
__device__ __forceinline__ int opaque_s(int v) { asm volatile("" : "+s"(v)); return v; }

__device__ __forceinline__ void mod_item(const Params& P, const int item, const int tid, float* lds) {
    const int l = item / 48, jb = item % 48;
    {
#pragma unroll 1
        for (int h = 0; h < 4; ++h) {
            const unsigned t4 = (unsigned)opaque_v(tid) * 4u;
            float cv[16];
#pragma unroll
            for (int i = 0; i < 16; ++i) cv[i] = *(const float*)((const char*)(P.c + 512 * (16 * h + i)) + t4);
#pragma unroll
            for (int i = 0; i < 16; ++i) *(float*)((char*)(lds + 512 * (16 * h + i)) + t4) = cv[i] / (1.f + __expf(-cv[i]));
        }
    }
    __syncthreads();
    const int jl = tid & 63, kg = __builtin_amdgcn_readfirstlane(tid >> 6);
    float acc[32];
#pragma unroll
    for (int b = 0; b < 32; ++b) acc[b] = 0.f;
    const float* wp = P.w_ada + ((size_t)l * DM + kg * 128) * 3072 + jb * 64;
    float wa[32], wb[32];
#define MOD_LOAD(w_, c_) do { _Pragma("unroll") for (int r_ = 0; r_ < 32; ++r_) w_[r_] = (wp + (size_t)(32 * (c_) + r_) * 3072)[(unsigned)jl]; } while (0)
#define MOD_FMA(w_, c_) do { _Pragma("unroll") for (int s_ = 0; s_ < 8; ++s_) { _Pragma("unroll") for (int b = 0; b < 32; ++b) { const float4 cv = *(const float4*)(lds + b * DM + kg * 128 + 32 * (c_) + 4 * s_); \
        acc[b] += cv.x * w_[4 * s_] + cv.y * w_[4 * s_ + 1] + cv.z * w_[4 * s_ + 2] + cv.w * w_[4 * s_ + 3]; } __builtin_amdgcn_sched_barrier(0); } } while (0)
    MOD_LOAD(wa, 0); MOD_LOAD(wb, 1); MOD_FMA(wa, 0); MOD_LOAD(wa, 2); MOD_FMA(wb, 1); MOD_LOAD(wb, 3); MOD_FMA(wa, 2); MOD_FMA(wb, 3);
#undef MOD_LOAD
#undef MOD_FMA
    __syncthreads();
#pragma unroll
    for (int b = 0; b < 32; ++b) lds[(kg * 32 + b) * 64 + jl] = acc[b];
    __syncthreads();
#pragma unroll
    for (int i = 0; i < 4; ++i) {
        const int idx = tid + 512 * i, b = idx >> 6, j = idx & 63;
        float s = P.b_ada[l * 3072 + jb * 64 + j];
#pragma unroll
        for (int g = 0; g < 8; ++g) s += lds[(g * 32 + b) * 64 + j];
        P.mod[((size_t)l * 32 + b) * 3072 + jb * 64 + j] = s;
    }
    __syncthreads();
}
__device__ __forceinline__ void transpose_tile_wave(const float* W, int ldw, bf16_t* WT, int kt, int nt, int kind, float* scr, const int lane) {
    int n = nt * 64 + lane;
    int src;
    if (kind == 0) {
        n = pg8::slot_tile(n >> 8) * 256 + (n & 255);
        if (n < 1024) src = n; else if (n < 1536) src = n + 16;
        else if (n < 2560) { const int i = (n - 1536) >> 8, w = (n - 1536) & 255; src = (w < 128) ? 1552 + 128 * i + w : 2576 + 128 * i + (w - 128); }
        else src = 2064 + (n - 2560);
    } else src = n;
    const float* wp = W + (size_t)kt * 64 * ldw + src;
#pragma unroll 16
    for (int i = 0; i < 64; ++i) scr[i * 65 + lane] = wp[(size_t)i * ldw];
    const int nl0 = lane >> 3, kc = lane & 7;
#pragma unroll
    for (int j = 0; j < 8; ++j) {
        const int nl = j * 8 + nl0;
        const float* sp = scr + (kc * 8) * 65 + nl;
        uint4 o;
        o.x = (unsigned)f2bf(sp[0 * 65]) | ((unsigned)f2bf(sp[1 * 65]) << 16); o.y = (unsigned)f2bf(sp[2 * 65]) | ((unsigned)f2bf(sp[3 * 65]) << 16);
        o.z = (unsigned)f2bf(sp[4 * 65]) | ((unsigned)f2bf(sp[5 * 65]) << 16); o.w = (unsigned)f2bf(sp[6 * 65]) | ((unsigned)f2bf(sp[7 * 65]) << 16);
        *(uint4*)(WT + (size_t)(nt * 64 + nl) * DM + kt * 64 + kc * 8) = o;
    }
}
__device__ __forceinline__ void wprep_tile(const Params& P, int it, float* scr, const int lane) {
    constexpr int T_IN = (NWT / 64) * (DM / 64);
    constexpr int T_OUT = (DM / 64) * (DM / 64);
    const int l = it / (T_IN + T_OUT); int r = it % (T_IN + T_OUT);
    if (r < T_IN) transpose_tile_wave(P.w_in + (size_t)l * DM * INW, INW, P.wt_in + (size_t)l * NWT * DM, r % 16, r / 16, 0, scr, lane);
    else { r -= T_IN; transpose_tile_wave(P.w_out + (size_t)l * DM * DM, DM, P.wt_out + (size_t)l * DM * DM, r % 16, r / 16, 1, scr, lane); }
}
__device__ __forceinline__ void ph_prologue(const Params& P, float* lds, const int tid, const int bid, const int part) {
    constexpr int NTILES = NL * ((NWT / 64) * (DM / 64) + (DM / 64) * (DM / 64));
    if (part == 0) { for (int it = bid; it < 192; it += gridDim.x) mod_item(P, it, tid, lds); return; }
    const int w = __builtin_amdgcn_readfirstlane(tid >> 6), lane = tid & 63;
    float* scr = lds + w * (64 * 65);
    for (int it = bid * 8 + w; it < NTILES; it += (int)gridDim.x * 8) wprep_tile(P, it, scr, lane);
}

__device__ __forceinline__ unsigned pk_bf16_rne(float lo, float hi) { unsigned r; asm volatile("v_cvt_pk_bf16_f32 %0, %1, %2" : "=v"(r) : "v"(lo), "v"(hi)); return r; }
typedef short nbf16x8 __attribute__((ext_vector_type(8)));
typedef float nf32x4 __attribute__((ext_vector_type(4)));
constexpr int NRM_WT_OFF = 12288, NRM_WT_PITCH = 2064;
constexpr int NRM_HB_OFF = 49152, NRM_HB_PITCH = 2112;
__device__ __forceinline__ void norm_item(const Params& P, const int l, const int item, const int tid, float* lds) {
    const int b = item >> 3, sub = item & 7;
    float* GS = lds;
    float* SH = lds + 1024;
    unsigned char* WT = (unsigned char*)lds + NRM_WT_OFF;
    const int lane = tid & 63, wv_ = __builtin_amdgcn_readfirstlane(tid >> 6);
    unsigned char* HB = (unsigned char*)lds + NRM_HB_OFF + wv_ * (4 * NRM_HB_PITCH);
    const int row0 = b * SEQ + sub * 8 + wv_;
    constexpr int RS = 64;
    const bool xbf = (l >= 1);
    const float* xb = P.x + (size_t)row0 * DM;
    const bf16_t* xbb = ((l & 1) ? P.xb0 : P.xb1) + (size_t)row0 * DM;
    const unsigned lo4 = (unsigned)lane * 4u;
    float4 xv[4], rf[2][4]; uint2 rb[2][4];
#define NRM_CVT(dst, raw) do { dst.x = __uint_as_float(raw.x << 16); dst.y = __uint_as_float(raw.x & 0xffff0000u); dst.z = __uint_as_float(raw.y << 16); dst.w = __uint_as_float(raw.y & 0xffff0000u); } while (0)
#define NRM_LOAD(slot, i_) do { _Pragma("unroll") for (int j = 0; j < 4; ++j) { if (xbf) { const ntu2 t_ = LDNT((const ntu2*)((xbb + (size_t)(i_) * RS * DM + j * 256) + lo4)); rb[slot][j].x = t_.x; rb[slot][j].y = t_.y; } \
        else { const ntf4 t_ = LDNT((const ntf4*)((xb + (size_t)(i_) * RS * DM + j * 256) + lo4)); rf[slot][j].x = t_.x; rf[slot][j].y = t_.y; rf[slot][j].z = t_.z; rf[slot][j].w = t_.w; } } } while (0)
    NRM_LOAD(0, 0); NRM_LOAD(1, 1);
    {
        const float* mo = P.mod + ((size_t)(l < NL ? l : 0) * 32 + b) * 3072;
        for (int c = tid; c < DM; c += 512) {
            if (l < NL) { GS[c] = P.norm_g[l * DM + c] * (1.f + mo[1024 + c]); SH[c] = mo[c]; } else { GS[c] = P.final_g[c]; SH[c] = 0.f; }
        }
        if (l < NL) {
            const float* wa = P.w_in + (size_t)l * DM * INW + 1024;
#pragma unroll
            for (int i = 0; i < 2; ++i) {
                const int k = tid + 512 * i;
                const float4 r0 = *(const float4*)(wa + (size_t)k * INW), r1 = *(const float4*)(wa + (size_t)k * INW + 4), r2 = *(const float4*)(wa + (size_t)k * INW + 8), r3 = *(const float4*)(wa + (size_t)k * INW + 12);
                const float rv[16] = {r0.x, r0.y, r0.z, r0.w, r1.x, r1.y, r1.z, r1.w, r2.x, r2.y, r2.z, r2.w, r3.x, r3.y, r3.z, r3.w};
#pragma unroll
                for (int r = 0; r < 16; ++r) *(unsigned short*)(WT + r * NRM_WT_PITCH + k * 2) = (unsigned short)(pk_bf16_rne(rv[r], 0.f) & 0xffffu);
            }
        }
    }
    __syncthreads();
    for (int grp = 0; grp < 8; ++grp) {
#pragma unroll
        for (int rr = 0; rr < 4; ++rr) {
            const int i = grp * 4 + rr;
#pragma unroll
            for (int j = 0; j < 4; ++j) { if (xbf) NRM_CVT(xv[j], rb[rr & 1][j]); else xv[j] = rf[rr & 1][j]; }
            if (i + 2 < 32) NRM_LOAD(rr & 1, i + 2);
            float ss = 0.f;
#pragma unroll
            for (int j = 0; j < 4; ++j) {
                ss += xv[j].x * xv[j].x + xv[j].y * xv[j].y + xv[j].z * xv[j].z + xv[j].w * xv[j].w;
            }
            ss = wave_sum(ss);
            const float rstd = rsqrtf(ss * (1.f / DM) + EPS);
            if (l < NL) {
#pragma unroll
                for (int j = 0; j < 4; ++j) {
                    const float4 g = *(const float4*)(GS + j * 256 + lane * 4), sh = *(const float4*)(SH + j * 256 + lane * 4);
                    uint2 w;
                    w.x = pk_bf16_rne(xv[j].x * rstd * g.x + sh.x, xv[j].y * rstd * g.y + sh.y);
                    w.y = pk_bf16_rne(xv[j].z * rstd * g.z + sh.z, xv[j].w * rstd * g.w + sh.w);
                    *(uint2*)((P.h + (size_t)(row0 + i * RS) * DM + j * 256) + lo4) = w;
                    *(uint2*)(HB + rr * NRM_HB_PITCH + (j * 256 + lane * 4) * 2) = w;
                }
            } else {
#pragma unroll
                for (int j = 0; j < 4; ++j) {
                    const float4 g = *(const float4*)(GS + j * 256 + lane * 4);
                    float4 o; o.x = xv[j].x * rstd * g.x; o.y = xv[j].y * rstd * g.y; o.z = xv[j].z * rstd * g.z; o.w = xv[j].w * rstd * g.w;
                    *(float4*)((P.out + (size_t)(row0 + i * RS) * DM + j * 256) + lo4) = o;
                }
            }
        }
        if (l < NL) {
            nf32x4 acc = {0.f, 0.f, 0.f, 0.f};
            const unsigned char* ap = WT + (lane & 15) * NRM_WT_PITCH + (lane >> 4) * 16;
            const unsigned char* bp = HB + (lane & 3) * NRM_HB_PITCH + (lane >> 4) * 16;
#pragma unroll 8
            for (int s = 0; s < 32; ++s) {
                const nbf16x8 af = *(const nbf16x8*)(ap + 64 * s), bf = *(const nbf16x8*)(bp + 64 * s);
                acc = __builtin_amdgcn_mfma_f32_16x16x32_bf16(af, bf, acc, 0, 0, 0);
            }
            if ((lane & 15) < 4) *(nf32x4*)(P.alr + (size_t)(row0 + (grp * 4 + (lane & 15)) * RS) * 16 + (lane >> 4) * 4) = acc;
        }
    }
    __syncthreads();
}
__device__ __forceinline__ void ph_norm(const Params& P, int l, const int tid, const int bid, float* lds) {
    for (int item = bid; item < 256; item += gridDim.x) norm_item(P, l, item, tid, lds);
}

typedef short mbf16x8 __attribute__((ext_vector_type(8)));
typedef short ms16x4 __attribute__((ext_vector_type(4)));
typedef float mf32x16 __attribute__((ext_vector_type(16)));
typedef float mf32x4 __attribute__((ext_vector_type(4)));
typedef float mf32x2 __attribute__((ext_vector_type(2)));
typedef unsigned mu32x4 __attribute__((ext_vector_type(4)));
typedef unsigned mu32x2 __attribute__((ext_vector_type(2)));
__device__ __forceinline__ unsigned off_b(unsigned row, unsigned ch) { return 256u * row + 16u * (ch ^ (((row & 3u) << 2) | ((row >> 2) & 3u))); }
__device__ __forceinline__ mbf16x8 frag_row(const LAS unsigned char* img, int row0, int cb, int ks, int lane) {
    return *(const LAS mbf16x8*)(img + off_b((unsigned)(row0 + (lane & 31)), (unsigned)(cb + 2 * ks + (lane >> 5))));
}
__device__ __forceinline__ mbf16x8 frag_tr(const LAS unsigned char* img, int row0, int c, int ks, int lane) {
    const unsigned h = lane >> 5, blk = (lane >> 4) & 1, q = (lane & 15) >> 2, p = lane & 3;
    const unsigned r = (unsigned)row0 + 16u * ks + 8u * h + q, chn = 4u * c + 2u * blk + (p >> 1);
    const ms16x4 lo = __builtin_amdgcn_ds_read_tr16_b64_v4i16((LAS ms16x4*)(img + off_b(r, chn) + 8u * (p & 1)));
    const ms16x4 hi = __builtin_amdgcn_ds_read_tr16_b64_v4i16((LAS ms16x4*)(img + off_b(r + 4u, chn) + 8u * (p & 1)));
    return (mbf16x8){lo[0], lo[1], lo[2], lo[3], hi[0], hi[1], hi[2], hi[3]};
}
__device__ __forceinline__ unsigned pk_bf16(float lo, float hi) { unsigned r; asm volatile("v_cvt_pk_bf16_f32 %0, %1, %2" : "=v"(r) : "v"(lo), "v"(hi)); return r; }
__device__ __forceinline__ float bflo(unsigned w) { return __uint_as_float(w << 16); }
__device__ __forceinline__ float bfhi(unsigned w) { return __uint_as_float(w & 0xffff0000u); }
#define WG_BARRIER() __syncthreads()

__device__ __forceinline__ void gla_stream(const Params& P, const int l, const int tid0, const int wgi, LAS unsigned char* lds) {
    const int w = __builtin_amdgcn_readfirstlane(tid0 >> 6);
    const int b = wgi >> 2, hd = wgi & 3;
    const int vt = w & 3, hh = w >> 2;
    LAS unsigned char* QK = lds;
    LAS unsigned char* VI = lds + 16384;
    LAS unsigned char* AI = lds + 32768;
    LAS unsigned char* ST = lds + 49152;
    LAS float* OS = (LAS float*)(lds + 81920);
    LAS float* ALR = (LAS float*)(lds + 114688);
    LAS float* SEG = (LAS float*)(lds + 118784);
    LAS float* EGL = (LAS float*)(lds + 120832);
    LAS float* ZZ = (LAS float*)(lds + 121088);
    mu32x4 w2h, w2l;
    { const unsigned ln = (unsigned)tid0 & 63u; const int zd = (w >> 1) & 1;
      float wv[8];
#pragma unroll
      for (int j = 0; j < 8; ++j) wv[j] = (P.w_alpha2 + ((size_t)l * 16 + j) * 256 + hd * 64 + 32 * zd)[(ln >> 5) * 2048u + (ln & 31u)];
      w2h.x = pk_bf16(wv[0], wv[1]); w2h.y = pk_bf16(wv[2], wv[3]); w2h.z = pk_bf16(wv[4], wv[5]); w2h.w = pk_bf16(wv[6], wv[7]);
      w2l.x = pk_bf16(wv[0] - bflo(w2h.x), wv[1] - bfhi(w2h.x)); w2l.y = pk_bf16(wv[2] - bflo(w2h.y), wv[3] - bfhi(w2h.y));
      w2l.z = pk_bf16(wv[4] - bflo(w2h.z), wv[5] - bfhi(w2h.z)); w2l.w = pk_bf16(wv[6] - bflo(w2h.w), wv[7] - bfhi(w2h.w)); }
    const float bac = (P.b_alpha + l * 256 + hd * 64)[(unsigned)tid0 & 63u];
    float gn[16];
    { const unsigned es = (unsigned)tid0 & 7u;
#pragma unroll
      for (int j = 0; j < 16; ++j) gn[j] = (P.gla_norm_g + l * 512 + hd * 128 + j)[es * 16u]; }
#pragma unroll
    for (int i = 0; i < 4; ++i) *(LAS mu32x4*)(ST + (tid0 + 512 * i) * 16) = (mu32x4){0u, 0u, 0u, 0u};
    mf32x16 acc6;
#pragma unroll
    for (int i = 0; i < 16; ++i) acc6[i] = 0.f;
    const bf16_t* pb = P.p + (size_t)b * SEQ * PW;
    const float* ab = P.alr + (size_t)b * SEQ * 16;
    bf16_t* cbp = P.cat + (size_t)b * SEQ * DM + hd * 128;
    unsigned short qvA[8], kvA[8], qvB[8], kvB[8]; mf32x2 alA, alB; mu32x4 vvA[2], rvA[2], vvB[2], rvB[2];
#define GLA_ZTILE(lane_) do { const int zt_ = w & 1, zd_ = (w >> 1) & 1; \
        const LAS mf32x4* ap_ = (const LAS mf32x4*)(ALR + (32 * zt_ + ((lane_) & 31)) * 16 + 8 * ((lane_) >> 5)); \
        const mf32x4 a0_ = ap_[0], a1_ = ap_[1]; \
        mu32x4 ah_, al_; \
        ah_.x = pk_bf16(a0_[0], a0_[1]); ah_.y = pk_bf16(a0_[2], a0_[3]); ah_.z = pk_bf16(a1_[0], a1_[1]); ah_.w = pk_bf16(a1_[2], a1_[3]); \
        al_.x = pk_bf16(a0_[0] - bflo(ah_.x), a0_[1] - bfhi(ah_.x)); al_.y = pk_bf16(a0_[2] - bflo(ah_.y), a0_[3] - bfhi(ah_.y)); \
        al_.z = pk_bf16(a1_[0] - bflo(ah_.z), a1_[1] - bfhi(ah_.z)); al_.w = pk_bf16(a1_[2] - bflo(ah_.w), a1_[3] - bfhi(ah_.w)); \
        mf32x16 z_; \
_Pragma("unroll") \
        for (int i_ = 0; i_ < 16; ++i_) z_[i_] = 0.f; \
        z_ = __builtin_amdgcn_mfma_f32_32x32x16_bf16(__builtin_bit_cast(mbf16x8, al_), __builtin_bit_cast(mbf16x8, w2h), z_, 0, 0, 0); \
        z_ = __builtin_amdgcn_mfma_f32_32x32x16_bf16(__builtin_bit_cast(mbf16x8, ah_), __builtin_bit_cast(mbf16x8, w2l), z_, 0, 0, 0); \
        z_ = __builtin_amdgcn_mfma_f32_32x32x16_bf16(__builtin_bit_cast(mbf16x8, ah_), __builtin_bit_cast(mbf16x8, w2h), z_, 0, 0, 0); \
        LAS float* zp_ = ZZ + (32 * zt_ + 4 * ((lane_) >> 5)) * 64 + 32 * zd_ + ((lane_) & 31); \
_Pragma("unroll") \
        for (int r_ = 0; r_ < 16; ++r_) zp_[((r_ & 3) + 8 * (r_ >> 2)) * 64] = z_[r_]; } while (0)
#define GLA_LOAD_QK(c, lane_, q_, k_) do { _Pragma("unroll") for (int i = 0; i < 8; ++i) { const bf16_t* rp = pb + (size_t)((c) * 64 + 8 * w + i) * PW + hd * 64; q_[i] = LDNT(rp + (unsigned)(lane_)); k_[i] = LDNT(rp + 256 + (unsigned)(lane_)); } } while (0)
#define GLA_LOAD_A(c, tid_, a_) do { a_ = LDNT((const mf32x2*)((ab + (size_t)(c) * 64 * 16) + (unsigned)(tid_) * 2u)); } while (0)
#define GLA_LOAD_AV(c, tid_, a_, v_) do { (void)(a_); \
        const unsigned vo_ = ((unsigned)(tid_) >> 4) * (unsigned)PW + ((unsigned)(tid_) & 15u) * 8u; \
        _Pragma("unroll") for (int i = 0; i < 2; ++i) v_[i] = LDNT((const mu32x4*)((pb + (size_t)((c) * 64 + 32 * i) * PW + 512 + hd * 128) + vo_)); } while (0)
#define GLA_LOAD_R(c, tid_, r_) do { const unsigned ro_ = ((unsigned)(tid_) >> 3) * (unsigned)PW + ((unsigned)(tid_) & 7u) * 16u; \
        _Pragma("unroll") for (int i = 0; i < 2; ++i) r_[i] = LDNT((const mu32x4*)((pb + (size_t)(c) * 64 * PW + 1024 + hd * 128 + 8 * i) + ro_)); } while (0)
    GLA_LOAD_A(0, tid0, alA); GLA_LOAD_A(1, tid0, alB);
    GLA_LOAD_AV(0, tid0, alA, vvA); GLA_LOAD_QK(0, tid0 & 63, qvA, kvA); GLA_LOAD_R(0, tid0, rvA);
    GLA_LOAD_AV(1, tid0, alB, vvB); GLA_LOAD_QK(1, tid0 & 63, qvB, kvB); GLA_LOAD_R(1, tid0, rvB);
    *(LAS mf32x2*)(ALR + tid0 * 2) = alA;
    GLA_LOAD_A(2, tid0, alA);
    WG_BARRIER();
    if (w >= 4) GLA_ZTILE(tid0 & 63);
    WG_BARRIER();
#define GLA_CHUNK(C, S, T) do { const int c = (C); \
        const int tid = opaque_v(tid0);                   \
        const int lane = tid & 63, lh = lane >> 5, l31 = lane & 31; \
          \
        if (c + 1 < SEQ / 64) *(LAS mf32x2*)(ALR + tid * 2) = al##T; \
_Pragma("unroll") \
        for (int i = 0; i < 2; ++i) *(LAS mu32x4*)(VI + off_b((unsigned)(tid >> 4), (unsigned)(tid & 15)) + 8192 * i) = vv##S[i]; \
          \
        float Gl[8]; float cum = 0.f; float zr[8]; \
_Pragma("unroll") \
        for (int i = 0; i < 8; ++i) zr[i] = ZZ[(8 * w + i) * 64 + lane]; \
_Pragma("unroll") \
        for (int i = 0; i < 8; ++i) { \
            const float z = bac + zr[i]; \
            const float e = __builtin_amdgcn_exp2f(-1.4426950408889634f * fabsf(z)); \
            const float ls = fminf(z, 0.f) - 0.6931471805599453f * __builtin_amdgcn_logf(1.0f + e);     \
            cum += ls * (1.0f / 16.0f); \
            Gl[i] = cum; \
        } \
        SEG[w * 64 + lane] = cum; \
        WG_BARRIER(); \
        if (c + 2 < SEQ / 64) GLA_LOAD_AV(c + 2, tid, al##S, vv##S); \
        if (c + 3 < SEQ / 64) GLA_LOAD_A(c + 3, tid, al##T); \
        float pre = 0.f; \
_Pragma("unroll") \
        for (int ww = 0; ww < 7; ++ww) { const float sv = SEG[ww * 64 + lane]; pre += (ww < w) ? sv : 0.f; }     \
        if (w == 7) EGL[lane] = __builtin_amdgcn_exp2f(1.4426950408889634f * (pre + Gl[7])); \
        { \
            const unsigned qoff = off_b((unsigned)(8 * w), (unsigned)(lane >> 3)) + (lane & 7) * 2;         \
_Pragma("unroll") \
            for (int i = 0; i < 8; ++i) { \
                const float G = (pre + Gl[i]) * 1.4426950408889634f; \
                const float qt = __uint_as_float(((unsigned)qv##S[i]) << 16) * __builtin_amdgcn_exp2f(G); \
                const float kt = __uint_as_float(((unsigned)kv##S[i]) << 16) * __builtin_amdgcn_exp2f(-G); \
                const unsigned t = 8 * w + i; \
                (void)qoff; \
                *(LAS unsigned short*)(QK + off_b(t, (unsigned)(lane >> 3)) + (lane & 7) * 2) = (unsigned short)(pk_bf16(qt, 0.f) & 0xffffu); \
                *(LAS unsigned short*)(QK + off_b(t, 8u + (unsigned)(lane >> 3)) + (lane & 7) * 2) = (unsigned short)(pk_bf16(kt, 0.f) & 0xffffu); \
            } \
        } \
        WG_BARRIER(); \
        if (c + 2 < SEQ / 64) GLA_LOAD_QK(c + 2, lane, qv##S, kv##S); \
          \
        mbf16x8 vf[4]; \
_Pragma("unroll") \
        for (int ks = 0; ks < 4; ++ks) vf[ks] = frag_tr(VI, 0, vt, ks, lane); \
_Pragma("unroll") \
        for (int ks = 0; ks < 4; ++ks) { const mbf16x8 kf = frag_tr(QK, 0, 2 + hh, ks, lane); acc6 = __builtin_amdgcn_mfma_f32_32x32x16_bf16(kf, vf[ks], acc6, 0, 0, 0); } \
        if (w >= 4 && c + 1 < SEQ / 64) GLA_ZTILE(lane); \
        if (w < 3) { \
            const int tt = (w == 0) ? 0 : 1, st = (w == 2) ? 1 : 0; \
            mf32x16 a4; \
_Pragma("unroll") \
            for (int i = 0; i < 16; ++i) a4[i] = 0.f; \
_Pragma("unroll") \
            for (int ks = 0; ks < 4; ++ks) { const mbf16x8 ka = frag_row(QK, 32 * st, 8, ks, lane), qb = frag_row(QK, 32 * tt, 0, ks, lane); a4 = __builtin_amdgcn_mfma_f32_32x32x16_bf16(ka, qb, a4, 0, 0, 0); } \
              \
            const int t = 32 * tt + l31; \
_Pragma("unroll") \
            for (int g = 0; g < 4; ++g) { const int s0 = 32 * st + 8 * g + 4 * lh; \
                const float x0 = (s0 + 0 <= t) ? a4[4 * g + 0] : 0.f, x1 = (s0 + 1 <= t) ? a4[4 * g + 1] : 0.f, x2 = (s0 + 2 <= t) ? a4[4 * g + 2] : 0.f, x3 = (s0 + 3 <= t) ? a4[4 * g + 3] : 0.f; \
                mu32x2 wv; wv.x = pk_bf16(x0, x1); wv.y = pk_bf16(x2, x3); \
                *(LAS mu32x2*)(AI + off_b((unsigned)t, (unsigned)(4 * st + g)) + 8 * lh) = wv; } \
        } \
        WG_BARRIER(); \
          \
        { \
            mf32x16 a5; \
_Pragma("unroll") \
            for (int i = 0; i < 16; ++i) a5[i] = 0.f; \
_Pragma("unroll") \
            for (int ks = 0; ks < 4; ++ks) if (ks < 2 || hh == 1) { const mbf16x8 af = frag_row(AI, 32 * hh, 0, ks, lane); a5 = __builtin_amdgcn_mfma_f32_32x32x16_bf16(af, vf[ks], a5, 0, 0, 0); } \
_Pragma("unroll") \
            for (int ks = 0; ks < 4; ++ks) { const mbf16x8 qf = frag_row(QK, 32 * hh, 0, ks, lane), sf = frag_row(ST, 32 * vt, 0, ks, lane); a5 = __builtin_amdgcn_mfma_f32_32x32x16_bf16(qf, sf, a5, 0, 0, 0); } \
            LAS float* ob = OS + (32 * hh + 4 * lh) * 128 + 32 * vt + l31; \
_Pragma("unroll") \
            for (int r = 0; r < 16; ++r) ob[((r & 3) + 8 * (r >> 2)) * 128] = a5[r]; \
        } \
_Pragma("unroll") \
        for (int g = 0; g < 4; ++g) { const mf32x4 e4 = *(const LAS mf32x4*)(EGL + 32 * hh + 8 * g + 4 * lh); \
            acc6[4 * g + 0] *= e4[0]; acc6[4 * g + 1] *= e4[1]; acc6[4 * g + 2] *= e4[2]; acc6[4 * g + 3] *= e4[3]; } \
        WG_BARRIER(); \
          \
_Pragma("unroll") \
        for (int g = 0; g < 4; ++g) { mu32x2 wv; wv.x = pk_bf16(acc6[4 * g + 0], acc6[4 * g + 1]); wv.y = pk_bf16(acc6[4 * g + 2], acc6[4 * g + 3]); \
            *(LAS mu32x2*)(ST + off_b((unsigned)(32 * vt + l31), (unsigned)(4 * hh + g)) + 8 * lh) = wv; } \
        { \
            const unsigned et = (unsigned)tid >> 3, es = (unsigned)tid & 7u; \
            const LAS mf32x4* op = (const LAS mf32x4*)(OS + et * 128 + es * 16); \
            const mf32x4 o0 = op[0], o1 = op[1], o2 = op[2], o3 = op[3]; \
            float ss = o0[0] * o0[0] + o0[1] * o0[1] + o0[2] * o0[2] + o0[3] * o0[3] + o1[0] * o1[0] + o1[1] * o1[1] + o1[2] * o1[2] + o1[3] * o1[3] \
                     + o2[0] * o2[0] + o2[1] * o2[1] + o2[2] * o2[2] + o2[3] * o2[3] + o3[0] * o3[0] + o3[1] * o3[1] + o3[2] * o3[2] + o3[3] * o3[3]; \
            ss = red8(ss); \
            const float rs = rsqrtf(ss * (1.0f / 128.0f) + EPS); \
            mu32x4 w0, w1; \
            w0.x = pk_bf16(o0[0] * rs * gn[0] * bflo(rv##S[0].x), o0[1] * rs * gn[1] * bfhi(rv##S[0].x)); \
            w0.y = pk_bf16(o0[2] * rs * gn[2] * bflo(rv##S[0].y), o0[3] * rs * gn[3] * bfhi(rv##S[0].y)); \
            w0.z = pk_bf16(o1[0] * rs * gn[4] * bflo(rv##S[0].z), o1[1] * rs * gn[5] * bfhi(rv##S[0].z)); \
            w0.w = pk_bf16(o1[2] * rs * gn[6] * bflo(rv##S[0].w), o1[3] * rs * gn[7] * bfhi(rv##S[0].w)); \
            w1.x = pk_bf16(o2[0] * rs * gn[8] * bflo(rv##S[1].x), o2[1] * rs * gn[9] * bfhi(rv##S[1].x)); \
            w1.y = pk_bf16(o2[2] * rs * gn[10] * bflo(rv##S[1].y), o2[3] * rs * gn[11] * bfhi(rv##S[1].y)); \
            w1.z = pk_bf16(o3[0] * rs * gn[12] * bflo(rv##S[1].z), o3[1] * rs * gn[13] * bfhi(rv##S[1].z)); \
            w1.w = pk_bf16(o3[2] * rs * gn[14] * bflo(rv##S[1].w), o3[3] * rs * gn[15] * bfhi(rv##S[1].w)); \
            bf16_t* du = cbp + (size_t)c * 64 * DM;                          \
            const unsigned doff = et * (unsigned)DM + es * 16u; \
            store16_wt(du, doff * 2u, w0); store16_wt(du, doff * 2u + 16u, w1);        \
        } \
        if (c == 3) publish_count_wt(seam_cnt(P.ctl, l, b, 0), 1, tid);         \
        if (c == 7) publish_count_wt(seam_cnt(P.ctl, l, b, 1), 1, tid); \
        if (c == 11) publish_count_wt(seam_cnt(P.ctl, l, b, 2), 1, tid); \
        if (c == 23) publish_count_wt(seam_cnt(P.ctl, l, b, 3), 3, tid);        \
        if (c == 27) publish_count_wt(seam_cnt(P.ctl, l, b, 6), 1, tid);        \
        if (c + 2 < SEQ / 64) GLA_LOAD_R(c + 2, tid, rv##S); \
    } while (0)
    for (int c2 = 0; c2 < SEQ / 128; ++c2) {
        GLA_CHUNK(2 * c2, A, B);
        GLA_CHUNK(2 * c2 + 1, B, A);
    }
#undef GLA_CHUNK
    publish_count_wt(seam_cnt(P.ctl, l, b, 7), 1, tid0);
#undef GLA_LOAD_QK
#undef GLA_ZTILE
#undef GLA_LOAD_AV
#undef GLA_LOAD_A
#undef GLA_LOAD_R
}

template <int NKS> __device__ __forceinline__ void sg_mfma(const LAS unsigned char* WI, const LAS unsigned char* VN, LAS float* MX, const int tc0, const int lane) {
    constexpr int tr = NKS / 2 - 1;
    mbf16x8 af[NKS], b0[NKS], b1[NKS];
#pragma unroll
    for (int ks = 0; ks < NKS; ++ks) { af[ks] = frag_row(WI, 32 * tr, 0, ks, lane); b0[ks] = frag_tr(VN, 0, tc0, ks, lane); b1[ks] = frag_tr(VN, 0, tc0 + 1, ks, lane); }
    mf32x16 m0, m1;
#pragma unroll
    for (int i = 0; i < 16; ++i) { m0[i] = 0.f; m1[i] = 0.f; }
#pragma unroll
    for (int ks = 0; ks < NKS; ++ks) { m0 = __builtin_amdgcn_mfma_f32_32x32x16_bf16(af[ks], b0[ks], m0, 0, 0, 0); m1 = __builtin_amdgcn_mfma_f32_32x32x16_bf16(af[ks], b1[ks], m1, 0, 0, 0); }
    const int lh = lane >> 5, l31 = lane & 31;
    LAS float* mb = MX + (32 * tr + 4 * lh) * 128 + 32 * tc0 + l31;
#pragma unroll
    for (int r = 0; r < 16; ++r) { mb[((r & 3) + 8 * (r >> 2)) * 128] = m0[r]; mb[((r & 3) + 8 * (r >> 2)) * 128 + 32] = m1[r]; }
}
__device__ __forceinline__ void sg_stream(const Params& P, const int l, const int tid0, const int wgi, LAS unsigned char* lds) {
    const int w = __builtin_amdgcn_readfirstlane(tid0 >> 6);
    const int g = wgi & 3, cbase = (wgi >> 2) * 16;
    LAS unsigned char* WI = lds;
    LAS unsigned char* VN = lds + 32768;
    LAS float* MX = (LAS float*)(lds + 65536);
    {
        const int lr = tid0 >> 4, ch = tid0 & 15;
        const float* wu = P.w_spatial + ((size_t)l * 4 + g) * 128 * 128;
#pragma unroll
        for (int i = 0; i < 4; ++i) {
            const int row = lr + 32 * i;
            const float* wp = wu + (unsigned)(row * 128 + ch * 8);
            const float4 a = *(const float4*)wp, bq = *(const float4*)(wp + 4);
            const int s0 = ch * 8;
            mu32x4 wv;
            wv.x = pk_bf16(s0 + 0 <= row ? a.x : 0.f, s0 + 1 <= row ? a.y : 0.f); wv.y = pk_bf16(s0 + 2 <= row ? a.z : 0.f, s0 + 3 <= row ? a.w : 0.f);
            wv.z = pk_bf16(s0 + 4 <= row ? bq.x : 0.f, s0 + 5 <= row ? bq.y : 0.f); wv.w = pk_bf16(s0 + 6 <= row ? bq.z : 0.f, s0 + 7 <= row ? bq.w : 0.f);
            *(LAS mu32x4*)(WI + off_b((unsigned)lr, (unsigned)ch) + 8192 * i) = wv;
        }
    }
    float lg[8], lb[8], bs[4];
    { const unsigned ch = (unsigned)tid0 & 15u, lr = (unsigned)tid0 >> 4;
#pragma unroll
      for (int j = 0; j < 8; ++j) { lg[j] = (P.sg_ln_g + l * 512 + g * 128 + j)[ch * 8u]; lb[j] = (P.sg_ln_b + l * 512 + g * 128 + j)[ch * 8u]; }
#pragma unroll
      for (int i = 0; i < 4; ++i) bs[i] = (P.b_spatial + ((size_t)l * 4 + g) * 128 + 32 * i)[lr]; }
    mu32x4 vA[4], uA[4], vB[4], uB[4];
#define SG_LOAD(dst, chunk, col0, tid_) do { const unsigned so_ = ((unsigned)(tid_) >> 4) * (unsigned)PW + ((unsigned)(tid_) & 15u) * 8u; \
        _Pragma("unroll") for (int i = 0; i < 4; ++i) dst[i] = LDNT((const mu32x4*)((P.p + (size_t)((chunk) * 128 + 32 * i) * PW + (col0) + g * 128) + so_)); } while (0)
    SG_LOAD(vA, cbase, 2048, tid0); SG_LOAD(uA, cbase, 1536, tid0);
    SG_LOAD(vB, cbase + 1, 2048, tid0); SG_LOAD(uB, cbase + 1, 1536, tid0);
    const int tr = w >> 1, tc0 = (w & 1) * 2;
#define SG_UNIT(IT, vv, uv) do { \
        const int it = (IT); const int chunk = cbase + it; \
        const int tid = opaque_v(tid0); \
        const int lane = tid & 63, lh = lane >> 5, l31 = lane & 31, lr = tid >> 4, ch = tid & 15; \
          \
        { \
            LAS unsigned char* vb = VN + off_b((unsigned)lr, (unsigned)ch); \
            _Pragma("unroll") for (int i = 0; i < 4; ++i) { \
                float x[8] = {bflo(vv[i].x), bfhi(vv[i].x), bflo(vv[i].y), bfhi(vv[i].y), bflo(vv[i].z), bfhi(vv[i].z), bflo(vv[i].w), bfhi(vv[i].w)}; \
                float s = ((x[0] + x[1]) + (x[2] + x[3])) + ((x[4] + x[5]) + (x[6] + x[7])); \
                s = red16(s); \
                const float mu = s * (1.0f / 128.0f); \
                float q = 0.f; \
                _Pragma("unroll") for (int j = 0; j < 8; ++j) { x[j] -= mu; q += x[j] * x[j]; } \
                q = red16(q); \
                const float rs = rsqrtf(q * (1.0f / 128.0f) + EPS); \
                mu32x4 wv; \
                wv.x = pk_bf16(x[0] * rs * lg[0] + lb[0], x[1] * rs * lg[1] + lb[1]); wv.y = pk_bf16(x[2] * rs * lg[2] + lb[2], x[3] * rs * lg[3] + lb[3]); \
                wv.z = pk_bf16(x[4] * rs * lg[4] + lb[4], x[5] * rs * lg[5] + lb[5]); wv.w = pk_bf16(x[6] * rs * lg[6] + lb[6], x[7] * rs * lg[7] + lb[7]); \
                *(LAS mu32x4*)(vb + 8192 * i) = wv; \
            } \
        } \
        WG_BARRIER(); \
        if (it + 2 < 16) SG_LOAD(vv, chunk + 2, 2048, tid); \
          \
        if (tr == 0) sg_mfma<2>(WI, VN, MX, tc0, lane); else if (tr == 1) sg_mfma<4>(WI, VN, MX, tc0, lane); else if (tr == 2) sg_mfma<6>(WI, VN, MX, tc0, lane); else sg_mfma<8>(WI, VN, MX, tc0, lane); \
        WG_BARRIER(); \
          \
        { \
            bf16_t* cu = P.cat + (size_t)chunk * 128 * DM + 512 + g * 128; \
            const unsigned co = (unsigned)lr * (unsigned)DM + (unsigned)ch * 8u; \
            const LAS float* mr = MX + lr * 128 + ch * 8; \
            _Pragma("unroll") for (int i = 0; i < 4; ++i) { \
                const LAS mf32x4* mp = (const LAS mf32x4*)(mr + 32 * 128 * i); \
                const mf32x4 ma = mp[0], mb = mp[1]; \
                mu32x4 wv; \
                wv.x = pk_bf16(bflo(uv[i].x) * (ma[0] + bs[i]), bfhi(uv[i].x) * (ma[1] + bs[i])); \
                wv.y = pk_bf16(bflo(uv[i].y) * (ma[2] + bs[i]), bfhi(uv[i].y) * (ma[3] + bs[i])); \
                wv.z = pk_bf16(bflo(uv[i].z) * (mb[0] + bs[i]), bfhi(uv[i].z) * (mb[1] + bs[i])); \
                wv.w = pk_bf16(bflo(uv[i].w) * (mb[2] + bs[i]), bfhi(uv[i].w) * (mb[3] + bs[i])); \
                store16_wt(cu + (size_t)32 * i * DM, co * 2u, wv); \
            } \
        } \
        if (it == 7) publish_count_wt(seam_cnt(P.ctl, l, wgi >> 2, 0), 4, tid);            \
        if (it == 15) publish_count_wt(seam_cnt(P.ctl, l, wgi >> 2, 4), 4, tid);           \
        if (it + 2 < 16) SG_LOAD(uv, chunk + 2, 1536, tid); \
    } while (0)
    for (int it2 = 0; it2 < 8; ++it2) {
        SG_UNIT(2 * it2, vA, uA);
        SG_UNIT(2 * it2 + 1, vB, uB);
    }
#undef SG_UNIT
    WG_BARRIER();
#undef SG_LOAD
}
__device__ __forceinline__ void ph_mixers(const Params& P, const int l, const int tid, const int bid, LAS unsigned char* lds) {
    for (int item = bid; item < 256; item += gridDim.x) {
        if (item < 128) gla_stream(P, l, tid, item, lds);
        else sg_stream(P, l, tid, item - 128, lds);
    }
}

#define PHASE_IDS() int lane__; asm volatile("v_mbcnt_lo_u32_b32 %0, -1, 0\n\tv_mbcnt_hi_u32_b32 %0, -1, %0" : "=v"(lane__)); \
    const int tid = opaque_s(wave_s) * 64 + lane__; const int bid = opaque_s((int)blockIdx.x); (void)tid; (void)bid
__global__ void __launch_bounds__(512, 2) fwd_megakernel(Params P) {
    extern __shared__ __attribute__((aligned(16))) unsigned char smem[];
    float* lds = (float*)smem;
    cg::grid_group grid = cg::this_grid();
    const int wave_s = __builtin_amdgcn_readfirstlane((int)threadIdx.x >> 6);
    volatile LAS unsigned* misc = (volatile LAS unsigned*)((LAS unsigned char*)smem + MISC_OFF);
    if (threadIdx.x < 32) misc[threadIdx.x] = 0u;
    __syncthreads();
    const XcdBarrier bar = xcd_barrier_post(P.ctl, misc + 8);
    { PHASE_IDS(); ph_prologue(P, lds, tid, bid, 0); }
    grid.sync();
    for (int l = 0; l < NL; ++l) {
        { PHASE_IDS(); ph_norm(P, l, tid, bid, lds); if (l == 0) { __syncthreads(); ph_prologue(P, lds, tid, bid, 1); } }
        xcd_barrier(bar);
        { PHASE_IDS();
          pg8::Gemm g{P.h, P.wt_in + (size_t)l * NWT * DM, NT, NWT, DM}; pg8::StaticOrder S; S.init(NT, NWT, (int)gridDim.x, bid);
          pg8::EpiInprojMF e{P.p};
          pg8::gemm_phase<pg8::EpiInprojMF, pg8::StaticOrder, true, true>((PG8_LAS unsigned char*)smem, g, S, e, tid); }
        xcd_barrier(bar);
        { PHASE_IDS(); ph_mixers(P, l, tid, bid, (LAS unsigned char*)smem); }
        {
            PHASE_IDS();
            const bool isg = (bid < 128);
            const int ow = isg ? bid : (bid - 128); const int ob = ow & 31, opn = ow >> 5, oj0 = isg ? 5 : 0, on = isg ? 2 : 6;
            pg8::Gemm g{P.cat, P.wt_out + (size_t)l * DM * DM, NT, DM, DM};
            pg8::PanelOrder S{ob * 8 + oj0, on, opn, seam_cnt(P.ctl, l, ob, oj0), 8u, isg ? 99 : 5, isg ? 0 : 2};
            const float* gate = P.mod + (size_t)l * 32 * 3072 + 2048; bf16_t* xo = (l & 1) ? P.xb1 : P.xb0; const bf16_t* xi = (l & 1) ? P.xb0 : P.xb1;
            if (l == NL - 1) { pg8::EpiOutprojFinal e{xi, P.out, gate, P.final_g, (float*)((unsigned char*)P.ctl + CTL_BYTES), (PG8_LAS float*)((PG8_LAS unsigned char*)smem + 131072)};
                pg8::gemm_phase<pg8::EpiOutprojFinal, pg8::PanelOrder, true, true>((PG8_LAS unsigned char*)smem, g, S, e, tid); }
            else if (l == 0) { pg8::EpiOutprojRes<true> e{P.x, nullptr, xo, gate}; pg8::gemm_phase<pg8::EpiOutprojRes<true>, pg8::PanelOrder, true, true>((PG8_LAS unsigned char*)smem, g, S, e, tid); }
            else { pg8::EpiOutprojRes<false> e{nullptr, xi, xo, gate}; pg8::gemm_phase<pg8::EpiOutprojRes<false>, pg8::PanelOrder, true, true>((PG8_LAS unsigned char*)smem, g, S, e, tid); }
        }
        if (l + 1 < NL) xcd_barrier(bar);
    }
}

static inline size_t align_up(size_t v, size_t a) { return (v + a - 1) / a * a; }
extern "C" void kernel_launch(void* const* d_in, const int* in_sizes, int n_in, void* d_out, int out_size, void* d_ws, size_t ws_size, hipStream_t stream) {
    constexpr size_t kDynLds = LDS_BYTES;
    static int grid_blocks = 0;
    if (!grid_blocks) {
        int dev = 0, cus = 0, per_cu = 0;
        (void)hipGetDevice(&dev);
        (void)hipDeviceGetAttribute(&cus, hipDeviceAttributeMultiprocessorCount, dev);
        (void)hipFuncSetAttribute((const void*)fwd_megakernel, hipFuncAttributeMaxDynamicSharedMemorySize, (int)kDynLds);
        (void)hipOccupancyMaxActiveBlocksPerMultiprocessor(&per_cu, (const void*)fwd_megakernel, 512, kDynLds);
        if (per_cu < 1) per_cu = 1;
        if (per_cu > 1) per_cu = 1;
        grid_blocks = cus * per_cu;
        if (grid_blocks != 256) fprintf(stderr, "kernel_launch: this kernel's phase program is laid out for 256 workgroups (one per CU of an MI355X); got %d\n", grid_blocks);
    }
    Params p{};
    p.x = (const float*)d_in[0]; p.c = (const float*)d_in[1]; p.norm_g = (const float*)d_in[2]; p.w_ada = (const float*)d_in[3]; p.b_ada = (const float*)d_in[4];
    p.w_in = (const float*)d_in[5]; p.w_alpha2 = (const float*)d_in[6]; p.b_alpha = (const float*)d_in[7]; p.gla_norm_g = (const float*)d_in[8];
    p.sg_ln_g = (const float*)d_in[9]; p.sg_ln_b = (const float*)d_in[10]; p.w_spatial = (const float*)d_in[11]; p.b_spatial = (const float*)d_in[12];
    p.w_out = (const float*)d_in[13]; p.final_g = (const float*)d_in[14];
    p.out = (float*)d_out;
    unsigned char* ws = (unsigned char*)d_ws; size_t off = 0;
    auto carve = [&](size_t bytes) { void* r = ws + off; off = align_up(off + bytes, 256); return r; };
    p.ctl = (unsigned*)carve(CTL_BYTES + XCH_BYTES);
    p.mod = (float*)carve((size_t)NL * 32 * 3072 * 4);
    p.wt_in = (bf16_t*)carve((size_t)NL * NWT * DM * 2);
    p.wt_out = (bf16_t*)carve((size_t)NL * DM * DM * 2);
    p.h = (bf16_t*)carve((size_t)NT * DM * 2);
    p.p = (bf16_t*)carve((size_t)NT * PW * 2);
    p.alr = (float*)carve((size_t)NT * 16 * 4);
    p.cat = (bf16_t*)carve((size_t)NT * DM * 2);
    p.xb0 = (bf16_t*)carve((size_t)NT * DM * 2);
    p.xb1 = (bf16_t*)carve((size_t)NT * DM * 2);
    if (off > ws_size) { fprintf(stderr, "kernel_launch: workspace too small: need %zu have %zu\n", off, ws_size); return; }
    (void)hipMemsetAsync(p.ctl, 0, CTL_BYTES + XCH_BYTES, stream);
    void* args[] = {&p};
    hipError_t e = hipLaunchCooperativeKernel((const void*)fwd_megakernel, dim3(grid_blocks), dim3(512), args, kDynLds, stream);
    if (e != hipSuccess) fprintf(stderr, "cooperative launch failed: %s (grid %d)\n", hipGetErrorString(e), grid_blocks);
}
```

```cpp
#include <hip/hip_runtime.h>
#include <hip/hip_cooperative_groups.h>
#include <cstdio>
namespace cg = cooperative_groups;

typedef unsigned short bf16_t;
constexpr int NB = 32, SEQ = 2048, DM = 1024, NL = 4, NT = NB * SEQ;
constexpr int INW = 3088;
constexpr int PW = 2560;
constexpr int NWT = 3072;
constexpr float EPS = 1e-6f;
constexpr int LDS_BYTES = 147456, MISC_OFF = LDS_BYTES - 256;
constexpr size_t XCH_BYTES = 256 * 4 * 256 * 4;
constexpr size_t CTL_BYTES = 98304;

typedef float ntf4 __attribute__((ext_vector_type(4)));
typedef unsigned ntu2 __attribute__((ext_vector_type(2)));
typedef unsigned ntu4 __attribute__((ext_vector_type(4)));
#define LDNT(p) __builtin_nontemporal_load(p)
__device__ __forceinline__ float bf2f(bf16_t v) { return __uint_as_float(((unsigned)v) << 16); }
__device__ __forceinline__ bf16_t f2bf(float f) { unsigned u = __float_as_uint(f); u += 0x7FFFu + ((u >> 16) & 1u); return (bf16_t)(u >> 16); }
__device__ __forceinline__ float silu_f(float v) { return v / (1.f + expf(-v)); }
__device__ __forceinline__ float gelu_f(float v) { return 0.5f * v * (1.f + erff(v * 0.70710678118654752f)); }
template <int CTRL> __device__ __forceinline__ float dpp_mov(float v) { return __int_as_float(__builtin_amdgcn_update_dpp(0, __float_as_int(v), CTRL, 0xf, 0xf, true)); }
__device__ __forceinline__ float red4(float v) { v += dpp_mov<0xB1>(v); v += dpp_mov<0x4E>(v); return v; }
__device__ __forceinline__ float red8(float v) { v = red4(v); v += dpp_mov<0x141>(v); return v; }
__device__ __forceinline__ float red16(float v) { v = red8(v); v += dpp_mov<0x140>(v); return v; }
__device__ __forceinline__ float wave_sum(float v) {
    v = red16(v);
    const float a = __int_as_float(__builtin_amdgcn_readlane(__float_as_int(v), 0)), b = __int_as_float(__builtin_amdgcn_readlane(__float_as_int(v), 16));
    const float c = __int_as_float(__builtin_amdgcn_readlane(__float_as_int(v), 32)), d = __int_as_float(__builtin_amdgcn_readlane(__float_as_int(v), 48));
    return (a + b) + (c + d);
}

namespace pg8 {
#define PG8_LAS __attribute__((address_space(3)))
typedef unsigned short bf16_t;
typedef short bf16x8 __attribute__((ext_vector_type(8)));
typedef float f32x4 __attribute__((ext_vector_type(4)));
typedef unsigned u32x4 __attribute__((ext_vector_type(4)));
constexpr int BM = 256, BK = 64, HALF = 128, HTB = HALF * BK * 2  , STAGE_BYTES = 8 * HTB, NXCD = 8, WGM = 8;

__host__ __device__ __forceinline__ int lds_byte(int r, int c) { const int st = (r >> 4) * 2 + (c >> 5), rr = r & 15, cc = c & 31, ob = rr * 64 + cc * 2; return st * 1024 + (ob ^ (((ob >> 9) & 1) << 5)); }
__host__ __device__ __forceinline__ void stage_rc(int b, int& R, int& C) { const int st = b / 1024, sb = b % 1024, swz = sb ^ (((sb >> 9) & 1) << 5); R = (st >> 1) * 16 + swz / 64; C = (st & 1) * 32 + (swz % 64) / 2; }
__host__ __device__ __forceinline__ int perm32(int rho) { const int n = rho >> 4, i = rho & 15; return 8 * (i >> 2) + 4 * n + (i & 3); }

struct Unit { int pm, pn; };
struct Gemm { const bf16_t* A; const bf16_t* Bt; int M, N, K; };

struct StaticOrder {
    int nM, nN, nwg, G, c;
    __host__ __device__ void init(int M, int N, int G_, int c_) { nM = M / BM; nN = N / BM; nwg = nM * nN; G = G_; c = c_; }
    __host__ __device__ bool next(int i, Unit& u) const {
        const long L = (long)i * G + c; if (L >= nwg) return false;
        int wgid = (int)L; { const int q = nwg / NXCD, r = nwg % NXCD, xcd = wgid % NXCD, off = wgid / NXCD; wgid = (xcd < r ? xcd * (q + 1) : r * (q + 1) + (xcd - r) * q) + off; }
        const int nig = WGM * nN, gid = wgid / nig, fm = gid * WGM, gsz = (nM - fm) < WGM ? (nM - fm) : WGM;
        u.pm = fm + ((wgid % nig) % gsz); u.pn = (wgid % nig) / gsz; return true;
    }
    __device__ __forceinline__ void a_ready(const Unit&) const {}
    __device__ __forceinline__ void done(const Unit&) const {}
};

struct PanelOrder {
    int pm0, n, pn; unsigned* cnt0; unsigned need; int skip_at, skip;
    __device__ __forceinline__ bool next(int i, Unit& u) const { if (i >= n) return false; u.pm = pm0 + i + (i >= skip_at ? skip : 0); u.pn = pn; return true; }
    __device__ __forceinline__ void a_ready(const Unit& u) const {
        if (threadIdx.x < 64) {
            unsigned* c = cnt0 + 16 * (u.pm - pm0); unsigned sp = 0u;
            while ((unsigned)__builtin_amdgcn_readfirstlane((int)__hip_atomic_load(c, __ATOMIC_RELAXED, __HIP_MEMORY_SCOPE_AGENT)) < need) { __builtin_amdgcn_s_sleep(2); if (++sp > (1u << 21)) break; }
        }
        asm volatile("" ::: "memory"); __builtin_amdgcn_s_barrier(); asm volatile("" ::: "memory");
    }
    __device__ __forceinline__ void done(const Unit&) const {}
};

__device__ __forceinline__ unsigned cvt_pk_bf16(float lo, float hi) { unsigned r; asm volatile("v_cvt_pk_bf16_f32 %0, %1, %2" : "=v"(r) : "v"(lo), "v"(hi)); return r; }
typedef float f32x2 __attribute__((ext_vector_type(2)));
__device__ __forceinline__ f32x2 gelu_den(f32x2 v) {
    const f32x2 x2 = v * v;
    f32x2 p = x2 * (-3.228972053e-06f) + 8.823774386e-05f; p = p * x2 + 3.602777123e-04f; p = p * x2 + (-1.052266981e-01f); p = p * x2 + (-2.302045381e+00f);
    const f32x2 w = p * v;
    f32x2 e; e.x = __builtin_amdgcn_exp2f(w.x); e.y = __builtin_amdgcn_exp2f(w.y);
    return e + 1.0f;
}
__device__ __forceinline__ f32x2 gelu_pk(f32x2 v) {
    const f32x2 d = gelu_den(v);
    f32x2 o; o.x = v.x * __builtin_amdgcn_rcpf(d.x); o.y = v.y * __builtin_amdgcn_rcpf(d.y); return o;
}

__device__ __forceinline__ float silu_fast(float v) { return v * __builtin_amdgcn_rcpf(1.0f + __builtin_amdgcn_exp2f(-1.4426950408889634f * v)); }
__device__ __forceinline__ f32x2 gelu_silu(f32x2 u, f32x2 r) {
    const f32x2 du = gelu_den(u), s = r * (-1.4426950408889634f);
    f32x2 er; er.x = __builtin_amdgcn_exp2f(s.x); er.y = __builtin_amdgcn_exp2f(s.y);
    const f32x2 dd = du * (er + 1.0f), n = u * r;
    f32x2 o; o.x = n.x * __builtin_amdgcn_rcpf(dd.x); o.y = n.y * __builtin_amdgcn_rcpf(dd.y); return o;
}
constexpr int PWc = 2560;
__host__ __device__ __forceinline__ int slot_tile(int slot) { return (int)((0x975486ba3210ull >> (4 * slot)) & 15ull); }
struct EpiInprojMF {
    static constexpr bool PERM = true, AFTER_DRAIN = false;
    bf16_t* P;
    template <int ACT> __device__ __forceinline__ void store_tile(const f32x4 (&acc)[2][2][4][2], bf16_t* base) const {
#pragma unroll
        for (int ai = 0; ai < 2; ++ai)
#pragma unroll
            for (int m = 0; m < 4; ++m) { bf16_t* rowp = base + (size_t)(ai * HALF + m * 16) * PWc;
#pragma unroll
                for (int bj = 0; bj < 2; ++bj) { f32x4 v0 = acc[ai][bj][m][0], v1 = acc[ai][bj][m][1];
                    if (ACT == 0) { v0 = v0 * 0.125f; v1 = v1 * 0.125f; }
                    if (ACT == 2) {
#pragma unroll
                        for (int j = 0; j < 4; ++j) { v0[j] = silu_fast(v0[j]); v1[j] = silu_fast(v1[j]); } }
                    if (ACT == 3) { f32x2 a = gelu_pk((f32x2){v0[0], v0[1]}), b = gelu_pk((f32x2){v0[2], v0[3]}), c = gelu_pk((f32x2){v1[0], v1[1]}), d = gelu_pk((f32x2){v1[2], v1[3]});
                        v0 = (f32x4){a.x, a.y, b.x, b.y}; v1 = (f32x4){c.x, c.y, d.x, d.y}; }
                    u32x4 w; w.x = cvt_pk_bf16(v0[0], v0[1]); w.y = cvt_pk_bf16(v0[2], v0[3]); w.z = cvt_pk_bf16(v1[0], v1[1]); w.w = cvt_pk_bf16(v1[2], v1[3]);
                    *(u32x4*)(rowp + bj * HALF) = w; } }
    }
    __device__ __forceinline__ void store_ur(const f32x4 (&acc)[2][2][4][2], bf16_t* base) const {
#pragma unroll
        for (int ai = 0; ai < 2; ++ai)
#pragma unroll
            for (int m = 0; m < 4; ++m) { bf16_t* rowp = base + (size_t)(ai * HALF + m * 16) * PWc;
                const f32x4 u0 = acc[ai][0][m][0], u1 = acc[ai][0][m][1], r0 = acc[ai][1][m][0], r1 = acc[ai][1][m][1];
                const f32x2 a = gelu_silu((f32x2){u0[0], u0[1]}, (f32x2){r0[0], r0[1]}), b = gelu_silu((f32x2){u0[2], u0[3]}, (f32x2){r0[2], r0[3]});
                const f32x2 c = gelu_silu((f32x2){u1[0], u1[1]}, (f32x2){r1[0], r1[1]}), d = gelu_silu((f32x2){u1[2], u1[3]}, (f32x2){r1[2], r1[3]});
                u32x4 w;
                w.x = cvt_pk_bf16(a.x, a.y); w.y = cvt_pk_bf16(b.x, b.y); w.z = cvt_pk_bf16(c.x, c.y); w.w = cvt_pk_bf16(d.x, d.y);
                *(u32x4*)rowp = w; }
    }
    __device__ __forceinline__ void operator()(const f32x4 (&acc)[2][2][4][2], const Unit& u, int wr, int wc, int fr, int fq) const {
        const int row0 = u.pm * BM + wr * 64 + fr, pn = slot_tile(u.pn);
        const int colb = (pn < 6) ? pn * BM : ((pn < 10) ? 1536 + 128 * (pn - 6) : 2048 + BM * (pn - 10));
        bf16_t* base = P + (size_t)row0 * PWc + colb + wc * 32 + 8 * fq;
        if (pn == 0) store_tile<0>(acc, base);
        else if (pn < 4) store_tile<1>(acc, base);
        else if (pn < 6) store_tile<2>(acc, base);
        else if (pn < 10) store_ur(acc, base);
        else store_tile<3>(acc, base);
    }
};
template <bool F32IN> struct EpiOutprojRes {
    static constexpr bool PERM = true, AFTER_DRAIN = false;
    const float* xin32; const bf16_t* xin16; bf16_t* xout; const float* gate;
    __device__ __forceinline__ void operator()(const f32x4 (&acc)[2][2][4][2], const Unit& u, int wr, int wc, int fr, int fq) const {
        const int b = u.pm >> 3;
        const size_t off0 = (size_t)(u.pm * BM + wr * 64 + fr) * 1024 + u.pn * BM + wc * 32 + 8 * fq;
        f32x4 gv[2][2];
#pragma unroll
        for (int bj = 0; bj < 2; ++bj)
#pragma unroll
            for (int n = 0; n < 2; ++n) gv[bj][n] = *(const f32x4*)(gate + (size_t)b * 3072 + u.pn * BM + wc * 32 + 8 * fq + bj * HALF + 4 * n);
        if constexpr (!F32IN) {
            u32x4 xi[2][4][2];
#pragma unroll
            for (int ai = 0; ai < 2; ++ai)
#pragma unroll
                for (int m = 0; m < 4; ++m)
#pragma unroll
                    for (int bj = 0; bj < 2; ++bj) xi[ai][m][bj] = *(const u32x4*)(xin16 + off0 + (size_t)(ai * HALF + m * 16) * 1024 + bj * HALF);
#pragma unroll
            for (int ai = 0; ai < 2; ++ai)
#pragma unroll
                for (int m = 0; m < 4; ++m)
#pragma unroll
                    for (int bj = 0; bj < 2; ++bj) { const u32x4 x = xi[ai][m][bj]; const f32x4 a0 = acc[ai][bj][m][0], a1 = acc[ai][bj][m][1], g0 = gv[bj][0], g1 = gv[bj][1];
                        u32x4 w;
                        w.x = cvt_pk_bf16(__uint_as_float(x.x << 16) + g0[0] * a0[0], __uint_as_float(x.x & 0xffff0000u) + g0[1] * a0[1]);
                        w.y = cvt_pk_bf16(__uint_as_float(x.y << 16) + g0[2] * a0[2], __uint_as_float(x.y & 0xffff0000u) + g0[3] * a0[3]);
                        w.z = cvt_pk_bf16(__uint_as_float(x.z << 16) + g1[0] * a1[0], __uint_as_float(x.z & 0xffff0000u) + g1[1] * a1[1]);
                        w.w = cvt_pk_bf16(__uint_as_float(x.w << 16) + g1[2] * a1[2], __uint_as_float(x.w & 0xffff0000u) + g1[3] * a1[3]);
                        *(u32x4*)(xout + off0 + (size_t)(ai * HALF + m * 16) * 1024 + bj * HALF) = w; }
        } else {
#pragma unroll
            for (int ai = 0; ai < 2; ++ai) {
                f32x4 xi[4][2][2];
#pragma unroll
                for (int m = 0; m < 4; ++m)
#pragma unroll
                    for (int bj = 0; bj < 2; ++bj)
#pragma unroll
                        for (int n = 0; n < 2; ++n) xi[m][bj][n] = *(const f32x4*)(xin32 + off0 + (size_t)(ai * HALF + m * 16) * 1024 + bj * HALF + 4 * n);
#pragma unroll
                for (int m = 0; m < 4; ++m)
#pragma unroll
                    for (int bj = 0; bj < 2; ++bj) { const f32x4 v0 = xi[m][bj][0] + gv[bj][0] * acc[ai][bj][m][0], v1 = xi[m][bj][1] + gv[bj][1] * acc[ai][bj][m][1];
                        u32x4 w; w.x = cvt_pk_bf16(v0[0], v0[1]); w.y = cvt_pk_bf16(v0[2], v0[3]); w.z = cvt_pk_bf16(v1[0], v1[1]); w.w = cvt_pk_bf16(v1[2], v1[3]);
                        *(u32x4*)(xout + off0 + (size_t)(ai * HALF + m * 16) * 1024 + bj * HALF) = w; }
            }
        }
    }
};

struct EpiOutprojFinal {
    static constexpr bool PERM = true, AFTER_DRAIN = false;
    const bf16_t* xin16; float* out; const float* gate; const float* fg;
    float* xch;
    PG8_LAS float* sl;
    __device__ __forceinline__ void operator()(f32x4 (&acc)[2][2][4][2], const Unit& u, int wr, int wc, int fr, int fq) const {
        const int b = u.pm >> 3;
        const int colu = u.pn * BM + wc * 32;
        const size_t rowu = (size_t)(u.pm * BM + wr * 64) * 1024 + colu;
        const unsigned lo = (unsigned)(fr * 1024 + 8 * fq) * 2u;
        const unsigned lc = (unsigned)(8 * fq) * 4u;
#define EF_ROW(arr, ai, m, bj) ((arr) + rowu + (size_t)((ai) * HALF + (m) * 16) * 1024 + (bj) * HALF)
        f32x4 gv[2][2];
#pragma unroll
        for (int bj = 0; bj < 2; ++bj)
#pragma unroll
            for (int n = 0; n < 2; ++n) gv[bj][n] = *(const f32x4*)((const char*)(gate + (size_t)b * 3072 + colu + bj * HALF + 4 * n) + lc);
        u32x4 xi[2][4][2];
#pragma unroll
        for (int ai = 0; ai < 2; ++ai)
#pragma unroll
            for (int m = 0; m < 4; ++m)
#pragma unroll
                for (int bj = 0; bj < 2; ++bj) xi[ai][m][bj] = *(const u32x4*)((const char*)EF_ROW(xin16, ai, m, bj) + lo);
        float ss[2][4];
#pragma unroll
        for (int ai = 0; ai < 2; ++ai)
#pragma unroll
            for (int m = 0; m < 4; ++m) { float s = 0.f;
#pragma unroll
                for (int bj = 0; bj < 2; ++bj) { const u32x4 x = xi[ai][m][bj]; const f32x4 a0 = acc[ai][bj][m][0], a1 = acc[ai][bj][m][1], g0 = gv[bj][0], g1 = gv[bj][1];
                    f32x4 y0, y1;
                    y0[0] = __uint_as_float(x.x << 16) + g0[0] * a0[0]; y0[1] = __uint_as_float(x.x & 0xffff0000u) + g0[1] * a0[1];
                    y0[2] = __uint_as_float(x.y << 16) + g0[2] * a0[2]; y0[3] = __uint_as_float(x.y & 0xffff0000u) + g0[3] * a0[3];
                    y1[0] = __uint_as_float(x.z << 16) + g1[0] * a1[0]; y1[1] = __uint_as_float(x.z & 0xffff0000u) + g1[1] * a1[1];
                    y1[2] = __uint_as_float(x.w << 16) + g1[2] * a1[2]; y1[3] = __uint_as_float(x.w & 0xffff0000u) + g1[3] * a1[3];
                    acc[ai][bj][m][0] = y0; acc[ai][bj][m][1] = y1;
                    s += (y0[0] * y0[0] + y0[1] * y0[1]) + (y0[2] * y0[2] + y0[3] * y0[3]) + (y1[0] * y1[0] + y1[1] * y1[1]) + (y1[2] * y1[2] + y1[3] * y1[3]); }
                ss[ai][m] = s; }
#pragma unroll
        for (int ai = 0; ai < 2; ++ai)
#pragma unroll
            for (int m = 0; m < 4; ++m) { float s = ss[ai][m]; s += __shfl_xor(s, 16); s += __shfl_xor(s, 32); if (fq == 0) sl[wc * 256 + ai * HALF + wr * 64 + m * 16 + fr] = s; }
        f32x4 fv[2][2];
#pragma unroll
        for (int bj = 0; bj < 2; ++bj)
#pragma unroll
            for (int n = 0; n < 2; ++n) fv[bj][n] = *(const f32x4*)((const char*)(fg + colu + bj * HALF + 4 * n) + lc);
        asm volatile("s_waitcnt lgkmcnt(0)" ::: "memory"); __builtin_amdgcn_s_barrier(); asm volatile("" ::: "memory");
        const unsigned t = (unsigned)((wr * 4 + wc) * 64 + fq * 16 + fr);
        if (wr == 0) {
            const float S = ((sl[t] + sl[256 + t]) + (sl[512 + t] + sl[768 + t])) + 1e-30f;
            float* xp = xch + (size_t)u.pm * 1024;
            __hip_atomic_store((xp + u.pn * 256) + t, S, __ATOMIC_RELAXED, __HIP_MEMORY_SCOPE_AGENT);
            const int q1 = (u.pn + 1) & 3, q2 = (u.pn + 2) & 3, q3 = (u.pn + 3) & 3;
            float s1, s2, s3; unsigned sp = 0u;
            for (;;) {
                s1 = __hip_atomic_load((xp + q1 * 256) + t, __ATOMIC_RELAXED, __HIP_MEMORY_SCOPE_AGENT);
                s2 = __hip_atomic_load((xp + q2 * 256) + t, __ATOMIC_RELAXED, __HIP_MEMORY_SCOPE_AGENT);
                s3 = __hip_atomic_load((xp + q3 * 256) + t, __ATOMIC_RELAXED, __HIP_MEMORY_SCOPE_AGENT);
                const bool ok = (s1 > 0.f) && (s2 > 0.f) && (s3 > 0.f);
                if (__builtin_amdgcn_ballot_w64(!ok) == 0ull) break;
                __builtin_amdgcn_s_sleep(1); if (++sp > (1u << 20)) break;
            }
            sl[1024 + t] = __builtin_amdgcn_rsqf(((S + s1) + (s2 + s3)) * (1.0f / 1024.0f) + 1e-6f);
        }
        asm volatile("s_waitcnt lgkmcnt(0)" ::: "memory"); __builtin_amdgcn_s_barrier(); asm volatile("" ::: "memory");
        const unsigned lo4 = (unsigned)(fr * 1024 + 8 * fq) * 4u;
#pragma unroll
        for (int ai = 0; ai < 2; ++ai)
#pragma unroll
            for (int m = 0; m < 4; ++m) { const float r = sl[1024 + ai * HALF + wr * 64 + m * 16 + fr];
#pragma unroll
                for (int bj = 0; bj < 2; ++bj) { float* op = (float*)((char*)EF_ROW(out, ai, m, bj) + lo4);
                    *(f32x4*)op = acc[ai][bj][m][0] * r * fv[bj][0]; *(f32x4*)(op + 4) = acc[ai][bj][m][1] * r * fv[bj][1]; } }
#undef EF_ROW
    }
};

template <class Epi, class Sched, bool ALIGN_EPI = false, bool SP2 = false>
__device__ __forceinline__ void gemm_phase(PG8_LAS unsigned char* lds, const Gemm g, const Sched& S, const Epi& E, const int tid) {
    const int wid = __builtin_amdgcn_readfirstlane(tid >> 6), lane = tid & 63, wr = wid >> 2, wc = wid & 3, fr = lane & 15, fq = lane >> 4;
    const int K = g.K, nt = K / BK;
    unsigned voffA[2], voffB[2];
#pragma unroll
    for (int i = 0; i < 2; ++i) { int R, C; stage_rc(tid * 16 + i * 8192, R, C); const int Rb = Epi::PERM ? ((R & ~31) + perm32(R & 31)) : R;
        voffA[i] = (unsigned)(R * K + C) * 2u; voffB[i] = (unsigned)(Rb * K + C) * 2u; }
    const size_t kstep = (size_t)(BK * 2);
    const size_t hstep = (size_t)HALF * K * 2;
    const size_t tstep = 2 * hstep;
    const unsigned ldsw = (unsigned)wid * 1024u;
    const int aoff = lds_byte(wr * 64 + fr, fq * 8), boff = lds_byte(wc * 32 + fr, fq * 8);
#define PG8_SA(b, h) (((b) * 2 + (h)) * HTB)
#define PG8_SB(b, h) ((4 + (b) * 2 + (h)) * HTB)
#define PG8_STAGE(bufoff, gbase, voff) do { _Pragma("unroll") for (int _i = 0; _i < 2; ++_i) \
        __builtin_amdgcn_global_load_lds((const unsigned*)((const char*)(gbase) + (voff)[_i]), (PG8_LAS unsigned*)(lds + (bufoff) + ldsw + _i * 8192), 16, 0, 0); } while (0)
#define PG8_LDA(dst, b, h) do { _Pragma("unroll") for (int m = 0; m < 4; ++m) _Pragma("unroll") for (int k = 0; k < 2; ++k) dst[m][k] = *(const PG8_LAS bf16x8*)(lds + PG8_SA(b, h) + aoff + m * 2048 + k * 1024); } while (0)
#define PG8_LDB(dst, b, h) do { _Pragma("unroll") for (int n = 0; n < 2; ++n) _Pragma("unroll") for (int k = 0; k < 2; ++k) dst[n][k] = *(const PG8_LAS bf16x8*)(lds + PG8_SB(b, h) + boff + n * 2048 + k * 1024); } while (0)
#define PG8_MMA(ai, bj, At, Bt) do { __builtin_amdgcn_s_setprio(1); _Pragma("unroll") for (int m = 0; m < 4; ++m) _Pragma("unroll") for (int n = 0; n < 2; ++n) _Pragma("unroll") for (int k = 0; k < 2; ++k) \
        acc[ai][bj][m][n] = __builtin_amdgcn_mfma_f32_16x16x32_bf16(Bt[n][k], At[m][k], acc[ai][bj][m][n], 0, 0, 0); __builtin_amdgcn_s_setprio(0); } while (0)
#define PG8_WAIT_V(n) asm volatile("s_waitcnt vmcnt(" #n ")" ::: "memory")
#define PG8_WAIT_L(n) asm volatile("s_waitcnt lgkmcnt(" #n ")" ::: "memory")
#define PG8_BAR __builtin_amdgcn_s_barrier()
#define PG8_SCHED __builtin_amdgcn_sched_barrier(0)
    Unit cur, nxt; int ui = 0;
    if (!S.next(0, cur)) return;
    f32x4 acc[2][2][4][2];
#pragma unroll
    for (int a = 0; a < 2; ++a)
#pragma unroll
        for (int b = 0; b < 2; ++b)
#pragma unroll
            for (int m = 0; m < 4; ++m)
#pragma unroll
                for (int n = 0; n < 2; ++n) acc[a][b][m][n] = (f32x4){0.f, 0.f, 0.f, 0.f};
    bf16x8 At[4][2], B0[2][2], B1[2][2];
    const char* cA = (const char*)g.A + (size_t)cur.pm * tstep; const char* cB = (const char*)g.Bt + (size_t)cur.pn * tstep;
    S.a_ready(cur);
    if constexpr (SP2) {
        PG8_STAGE(PG8_SB(0, 0), cB, voffB); PG8_STAGE(PG8_SB(0, 1), cB + hstep, voffB); PG8_STAGE(PG8_SA(0, 0), cA, voffA); PG8_STAGE(PG8_SA(0, 1), cA + hstep, voffA);
        if (wr == 1) PG8_BAR;
        PG8_WAIT_V(2); PG8_BAR;
        PG8_STAGE(PG8_SB(1, 0), cB + kstep, voffB); PG8_STAGE(PG8_SA(1, 0), cA + kstep, voffA); PG8_STAGE(PG8_SB(1, 1), cB + hstep + kstep, voffB);
        PG8_WAIT_V(6); PG8_BAR;
    } else {
        PG8_STAGE(PG8_SB(0, 0), cB, voffB); PG8_STAGE(PG8_SA(0, 0), cA, voffA); PG8_STAGE(PG8_SB(0, 1), cB + hstep, voffB); PG8_STAGE(PG8_SA(0, 1), cA + hstep, voffA);
        if (wr == 1) PG8_BAR;
        PG8_WAIT_V(4); PG8_BAR;
        PG8_STAGE(PG8_SB(1, 0), cB + kstep, voffB); PG8_STAGE(PG8_SA(1, 0), cA + kstep, voffA); PG8_STAGE(PG8_SB(1, 1), cB + hstep + kstep, voffB);
        PG8_WAIT_V(6); PG8_BAR;
    }
    for (;;) {
        const bool has_next = S.next(ui + 1, nxt);
        const char* nA = has_next ? (const char*)g.A + (size_t)nxt.pm * tstep : cA; const char* nB = has_next ? (const char*)g.Bt + (size_t)nxt.pn * tstep : cB;
        for (int t = 0; t < nt; t += 2) {
            const bool last = (t == nt - 2);
            const char* a1 = cA + (size_t)(t + 1) * kstep;
            const char* a2 = last ? nA : cA + (size_t)(t + 2) * kstep; const char* b2 = last ? nB : cB + (size_t)(t + 2) * kstep;
            const char* a3 = a2 + kstep; const char* b3 = b2 + kstep;
            if (last && has_next) S.a_ready(nxt);
            if constexpr (SP2) {
            PG8_LDB(B0, 0, 0); PG8_LDB(B1, 0, 1); PG8_SCHED; PG8_LDA(At, 0, 0); PG8_STAGE(PG8_SA(1, 1), a1 + hstep, voffA);
            PG8_WAIT_V(8); PG8_WAIT_L(0); PG8_BAR; PG8_MMA(0, 0, At, B0); PG8_MMA(0, 1, At, B1); PG8_BAR; PG8_SCHED;
            PG8_LDA(At, 0, 1); PG8_STAGE(PG8_SB(0, 0), b2, voffB); PG8_STAGE(PG8_SB(0, 1), b2 + hstep, voffB); PG8_STAGE(PG8_SA(0, 0), a2, voffA);
            PG8_WAIT_V(8); PG8_WAIT_L(0); PG8_BAR; PG8_MMA(1, 0, At, B0); PG8_MMA(1, 1, At, B1); PG8_BAR; PG8_SCHED;
            PG8_LDB(B0, 1, 0); PG8_LDB(B1, 1, 1); PG8_SCHED; PG8_LDA(At, 1, 0); PG8_STAGE(PG8_SA(0, 1), a2 + hstep, voffA);
            PG8_WAIT_V(8); PG8_WAIT_L(0); PG8_BAR; PG8_MMA(0, 0, At, B0); PG8_MMA(0, 1, At, B1); PG8_BAR; PG8_SCHED;
            PG8_LDA(At, 1, 1); PG8_STAGE(PG8_SB(1, 0), b3, voffB); PG8_STAGE(PG8_SB(1, 1), b3 + hstep, voffB); PG8_STAGE(PG8_SA(1, 0), a3, voffA);
            PG8_WAIT_V(8); PG8_WAIT_L(0); PG8_BAR; PG8_MMA(1, 0, At, B0); PG8_MMA(1, 1, At, B1); PG8_BAR; PG8_SCHED;
            } else {
            PG8_LDB(B0, 0, 0); PG8_SCHED; PG8_LDA(At, 0, 0); PG8_STAGE(PG8_SA(1, 1), a1 + hstep, voffA);
            PG8_WAIT_L(8); PG8_BAR; PG8_WAIT_L(0); PG8_MMA(0, 0, At, B0); PG8_BAR; PG8_SCHED;
            PG8_LDB(B1, 0, 1); PG8_STAGE(PG8_SB(0, 0), b2, voffB);
            PG8_BAR; PG8_WAIT_L(0); PG8_MMA(0, 1, At, B1); PG8_BAR;
            PG8_LDA(At, 0, 1); PG8_STAGE(PG8_SA(0, 0), a2, voffA);
            PG8_BAR; PG8_WAIT_L(0); PG8_MMA(1, 0, At, B0); PG8_BAR; PG8_SCHED;
            PG8_STAGE(PG8_SB(0, 1), b2 + hstep, voffB);
            PG8_WAIT_V(6); PG8_BAR; PG8_MMA(1, 1, At, B1); PG8_BAR;
            PG8_LDB(B0, 1, 0); PG8_SCHED; PG8_LDA(At, 1, 0); PG8_STAGE(PG8_SA(0, 1), a2 + hstep, voffA);
            PG8_WAIT_L(8); PG8_BAR; PG8_WAIT_L(0); PG8_MMA(0, 0, At, B0); PG8_BAR; PG8_SCHED;
            PG8_LDB(B1, 1, 1); PG8_STAGE(PG8_SB(1, 0), b3, voffB);
            PG8_BAR; PG8_WAIT_L(0); PG8_MMA(0, 1, At, B1); PG8_BAR;
            PG8_LDA(At, 1, 1); PG8_STAGE(PG8_SA(1, 0), a3, voffA);
            PG8_BAR; PG8_WAIT_L(0); PG8_MMA(1, 0, At, B0); PG8_BAR; PG8_SCHED;
            PG8_STAGE(PG8_SB(1, 1), b3 + hstep, voffB);
            PG8_WAIT_V(6); PG8_BAR; PG8_MMA(1, 1, At, B1); PG8_BAR;
            }
        }
        if constexpr (ALIGN_EPI) { if (wr == 0) PG8_BAR; }
        if constexpr (!Epi::AFTER_DRAIN) { E(acc, cur, wr, wc, fr, fq); S.done(cur); }
        if (!has_next) break;
#pragma unroll
        for (int a = 0; a < 2; ++a)
#pragma unroll
            for (int b = 0; b < 2; ++b)
#pragma unroll
                for (int m = 0; m < 4; ++m)
#pragma unroll
                    for (int n = 0; n < 2; ++n) acc[a][b][m][n] = (f32x4){0.f, 0.f, 0.f, 0.f};
        cur = nxt; cA = nA; cB = nB; ++ui;
        if constexpr (ALIGN_EPI) { if (wr == 1) PG8_BAR; }
    }
    PG8_WAIT_V(0);
    if constexpr (!ALIGN_EPI) { if (wr == 0) PG8_BAR; }
    PG8_BAR;
    if constexpr (Epi::AFTER_DRAIN) { E.fused(acc, cur, wr, wc, fr, fq, lds, wid, lane); S.done(cur); }
#undef PG8_SA
#undef PG8_SB
#undef PG8_STAGE
#undef PG8_LDA
#undef PG8_LDB
#undef PG8_MMA
#undef PG8_WAIT_V
#undef PG8_WAIT_L
#undef PG8_BAR
#undef PG8_SCHED
}
}

#define LAS __attribute__((address_space(3)))
#define XB_TMO      128
#define XB_XCNT(j)  (256  + 64 * (j))
#define XB_XSUB(j)  (1280 + 64 * (j))
#define XB_XGEN(j)  (2304 + 64 * (j))
#define XB_TOP      3328
#define XB_TOPGEN   3392
#define XCD_BAR_WORDS 3456
#define XB_SPIN_CAP (1u << 18)

__device__ __forceinline__ unsigned xb_ld(unsigned* p)              { return __hip_atomic_load(p, __ATOMIC_RELAXED, __HIP_MEMORY_SCOPE_AGENT); }
__device__ __forceinline__ unsigned xb_add(unsigned* p, unsigned v) { return __hip_atomic_fetch_add(p, v, __ATOMIC_RELAXED, __HIP_MEMORY_SCOPE_AGENT); }
__device__ __forceinline__ unsigned xb_xcc_id() { return (unsigned)__builtin_amdgcn_s_getreg((3 << 11) | 20) & 0xFu; }
#define XB_SPIN(cond, bar) do { unsigned _sp = 0; while (cond) { __builtin_amdgcn_s_sleep(1); \
    if ((++_sp & 255u) == 0u) { if (xb_ld(&(bar)[XB_TMO])) break; if (_sp > XB_SPIN_CAP) { atomicAdd(&(bar)[XB_TMO], 1u); break; } } } } while (0)

struct XcdBarrier {
    unsigned* bar; unsigned x;
    volatile LAS unsigned* st;
};

__device__ __forceinline__ XcdBarrier xcd_barrier_post(unsigned* bar, volatile LAS unsigned* st) {
    XcdBarrier b; b.bar = bar; b.x = xb_xcc_id(); b.st = st;
    if (threadIdx.x == 0) (void)xb_add(&bar[XB_XCNT(b.x)], 1u);
    return b;
}
__device__ __forceinline__ void xcd_barrier_complete(unsigned* bar, unsigned x, unsigned& nloc, unsigned& nx) {
    const unsigned G = gridDim.x * gridDim.y * gridDim.z;
    unsigned sum, cnt, mine, sp = 0u;
    for (;;) {
        sum = 0u; cnt = 0u; mine = 0u;
#pragma unroll
        for (unsigned j = 0; j < 16; ++j) { const unsigned c = xb_ld(&bar[XB_XCNT(j)]); sum += c; cnt += (c > 0u) ? 1u : 0u; mine = (j == x) ? c : mine; }
        if (sum == G) break;
        __builtin_amdgcn_s_sleep(1);
        if ((++sp & 255u) == 0u) { if (xb_ld(&bar[XB_TMO])) break; if (sp > XB_SPIN_CAP) { atomicAdd(&bar[XB_TMO], 1u); break; } }
    }
    nloc = mine > 0u ? mine : 1u; nx = cnt > 0u ? cnt : 1u;
}

__device__ __forceinline__ void xcd_barrier(const XcdBarrier& b) {
    asm volatile("s_waitcnt vmcnt(0)" ::: "memory");
    __syncthreads();
    if (threadIdx.x == 0) {
        unsigned* bar = b.bar;
        __builtin_amdgcn_s_waitcnt(0);
        unsigned nloc = b.st[0], nx = b.st[1];
        if (nloc == 0u) { xcd_barrier_complete(bar, b.x, nloc, nx); b.st[0] = nloc; b.st[1] = nx; }
        const unsigned old = xb_add(&bar[XB_XSUB(b.x)], 1u);
        const unsigned gen = old / nloc;
        if (old + 1u == (gen + 1u) * nloc) {
            __builtin_amdgcn_fence(__ATOMIC_RELEASE, "agent");
            asm volatile("s_waitcnt vmcnt(0)" ::: "memory");
            const unsigned og = xb_add(&bar[XB_TOP], 1u);
            const unsigned tg = og / nx;
            if (og + 1u == (tg + 1u) * nx) xb_add(&bar[XB_TOPGEN], 1u);
            else XB_SPIN(xb_ld(&bar[XB_TOPGEN]) == tg, bar);
            __builtin_amdgcn_fence(__ATOMIC_ACQUIRE, "agent");
            xb_add(&bar[XB_XGEN(b.x)], 1u);
            asm volatile("s_waitcnt vmcnt(0)" ::: "memory");
        } else {
            XB_SPIN(xb_ld(&bar[XB_XGEN(b.x)]) == gen, bar);
            __builtin_amdgcn_fence(__ATOMIC_ACQUIRE, "agent");
            asm volatile("s_waitcnt vmcnt(0)" ::: "memory");
        }
    }
    __syncthreads();
}


__device__ __forceinline__ unsigned* seam_cnt(unsigned* ctl, int l, int b, int j) { return ctl + 4096 + (((l * 32 + b) * 8 + j) * 16); }
typedef unsigned wtu32x4 __attribute__((ext_vector_type(4)));
__device__ __forceinline__ void store16_wt(void* base_uniform, unsigned byte_off, wtu32x4 v) {
    const __amdgpu_buffer_rsrc_t rs = __builtin_amdgcn_make_buffer_rsrc(base_uniform, 0, 0x7fffffff, 0x00020000);
    __builtin_amdgcn_raw_buffer_store_b128(v, rs, (int)byte_off, 0, 16);
}
__device__ __forceinline__ void publish_count_wt(unsigned* cnt, const int n, const int tid) {
    asm volatile("s_waitcnt vmcnt(0)" ::: "memory");
    __syncthreads();
    if (tid == 0) { for (int i = 0; i < n; ++i) (void)__hip_atomic_fetch_add(cnt + 16 * i, 1u, __ATOMIC_RELAXED, __HIP_MEMORY_SCOPE_AGENT); }
}

struct Params {
    const float *x, *c, *norm_g, *w_ada, *b_ada, *w_in, *w_alpha2, *b_alpha, *gla_norm_g, *sg_ln_g, *sg_ln_b, *w_spatial, *b_spatial, *w_out, *final_g;
    float* out;
    unsigned* ctl;
    float* mod;
    bf16_t* wt_in;
    bf16_t* wt_out;
    bf16_t* h;
    bf16_t* p;
    float* alr;
    bf16_t* cat;
    bf16_t* xb0;
    bf16_t* xb1;
};

#define GTID (bid * 512 + tid)
#define GSIZE ((int)(gridDim.x * 512))
__device__ __forceinline__ int opaque_v(int v) { asm volatile("" : "+v"(v)); return v; }
__device__ __forceinline__ int opaque_s(int v) { asm volatile("" : "+s"(v)); return v; }

__device__ __forceinline__ void mod_item(const Params& P, const int item, const int tid, float* lds) {
    const int l = item / 48, jb = item % 48;
    {
#pragma unroll 1
        for (int h = 0; h < 4; ++h) {
            const unsigned t4 = (unsigned)opaque_v(tid) * 4u;
            float cv[16];
#pragma unroll
            for (int i = 0; i < 16; ++i) cv[i] = *(const float*)((const char*)(P.c + 512 * (16 * h + i)) + t4);
#pragma unroll
            for (int i = 0; i < 16; ++i) *(float*)((char*)(lds + 512 * (16 * h + i)) + t4) = cv[i] / (1.f + __expf(-cv[i]));
        }
    }
    __syncthreads();
    const int jl = tid & 63, kg = __builtin_amdgcn_readfirstlane(tid >> 6);
    float acc[32];
#pragma unroll
    for (int b = 0; b < 32; ++b) acc[b] = 0.f;
    const float* wp = P.w_ada + ((size_t)l * DM + kg * 128) * 3072 + jb * 64;
    float wa[32], wb[32];
#define MOD_LOAD(w_, c_) do { _Pragma("unroll") for (int r_ = 0; r_ < 32; ++r_) w_[r_] = (wp + (size_t)(32 * (c_) + r_) * 3072)[(unsigned)jl]; } while (0)
#define MOD_FMA(w_, c_) do { _Pragma("unroll") for (int s_ = 0; s_ < 8; ++s_) { _Pragma("unroll") for (int b = 0; b < 32; ++b) { const float4 cv = *(const float4*)(lds + b * DM + kg * 128 + 32 * (c_) + 4 * s_); \
        acc[b] += cv.x * w_[4 * s_] + cv.y * w_[4 * s_ + 1] + cv.z * w_[4 * s_ + 2] + cv.w * w_[4 * s_ + 3]; } __builtin_amdgcn_sched_barrier(0); } } while (0)
    MOD_LOAD(wa, 0); MOD_LOAD(wb, 1); MOD_FMA(wa, 0); MOD_LOAD(wa, 2); MOD_FMA(wb, 1); MOD_LOAD(wb, 3); MOD_FMA(wa, 2); MOD_FMA(wb, 3);
#undef MOD_LOAD
#undef MOD_FMA
    __syncthreads();
#pragma unroll
    for (int b = 0; b < 32; ++b) lds[(kg * 32 + b) * 64 + jl] = acc[b];
    __syncthreads();
#pragma unroll
    for (int i = 0; i < 4; ++i) {
        const int idx = tid + 512 * i, b = idx >> 6, j = idx & 63;
        float s = P.b_ada[l * 3072 + jb * 64 + j];
#pragma unroll
        for (int g = 0; g < 8; ++g) s += lds[(g * 32 + b) * 64 + j];
        P.mod[((size_t)l * 32 + b) * 3072 + jb * 64 + j] = s;
    }
    __syncthreads();
}
__device__ __forceinline__ void transpose_tile_wave(const float* W, int ldw, bf16_t* WT, int kt, int nt, int kind, float* scr, const int lane) {
    int n = nt * 64 + lane;
    int src;
    if (kind == 0) {
        n = pg8::slot_tile(n >> 8) * 256 + (n & 255);
        if (n < 1024) src = n; else if (n < 1536) src = n + 16;
        else if (n < 2560) { const int i = (n - 1536) >> 8, w = (n - 1536) & 255; src = (w < 128) ? 1552 + 128 * i + w : 2576 + 128 * i + (w - 128); }
        else src = 2064 + (n - 2560);
    } else src = n;
    const float* wp = W + (size_t)kt * 64 * ldw + src;
#pragma unroll 16
    for (int i = 0; i < 64; ++i) scr[i * 65 + lane] = wp[(size_t)i * ldw];
    const int nl0 = lane >> 3, kc = lane & 7;
#pragma unroll
    for (int j = 0; j < 8; ++j) {
        const int nl = j * 8 + nl0;
        const float* sp = scr + (kc * 8) * 65 + nl;
        uint4 o;
        o.x = (unsigned)f2bf(sp[0 * 65]) | ((unsigned)f2bf(sp[1 * 65]) << 16); o.y = (unsigned)f2bf(sp[2 * 65]) | ((unsigned)f2bf(sp[3 * 65]) << 16);
        o.z = (unsigned)f2bf(sp[4 * 65]) | ((unsigned)f2bf(sp[5 * 65]) << 16); o.w = (unsigned)f2bf(sp[6 * 65]) | ((unsigned)f2bf(sp[7 * 65]) << 16);
        *(uint4*)(WT + (size_t)(nt * 64 + nl) * DM + kt * 64 + kc * 8) = o;
    }
}
__device__ __forceinline__ void wprep_tile(const Params& P, int it, float* scr, const int lane) {
    constexpr int T_IN = (NWT / 64) * (DM / 64);
    constexpr int T_OUT = (DM / 64) * (DM / 64);
    const int l = it / (T_IN + T_OUT); int r = it % (T_IN + T_OUT);
    if (r < T_IN) transpose_tile_wave(P.w_in + (size_t)l * DM * INW, INW, P.wt_in + (size_t)l * NWT * DM, r % 16, r / 16, 0, scr, lane);
    else { r -= T_IN; transpose_tile_wave(P.w_out + (size_t)l * DM * DM, DM, P.wt_out + (size_t)l * DM * DM, r % 16, r / 16, 1, scr, lane); }
}
__device__ __forceinline__ void ph_prologue(const Params& P, float* lds, const int tid, const int bid, const int part) {
    constexpr int NTILES = NL * ((NWT / 64) * (DM / 64) + (DM / 64) * (DM / 64));
    if (part == 0) { for (int it = bid; it < 192; it += gridDim.x) mod_item(P, it, tid, lds); return; }
    const int w = __builtin_amdgcn_readfirstlane(tid >> 6), lane = tid & 63;
    float* scr = lds + w * (64 * 65);
    for (int it = bid * 8 + w; it < NTILES; it += (int)gridDim.x * 8) wprep_tile(P, it, scr, lane);
}

__device__ __forceinline__ unsigned pk_bf16_rne(float lo, float hi) { unsigned r; asm volatile("v_cvt_pk_bf16_f32 %0, %1, %2" : "=v"(r) : "v"(lo), "v"(hi)); return r; }
typedef short nbf16x8 __attribute__((ext_vector_type(8)));
typedef float nf32x4 __attribute__((ext_vector_type(4)));
constexpr int NRM_WT_OFF = 12288, NRM_WT_PITCH = 2064;
constexpr int NRM_HB_OFF = 49152, NRM_HB_PITCH = 2112;
__device__ __forceinline__ void norm_item(const Params& P, const int l, const int item, const int tid, float* lds) {
    const int b = item >> 3, sub = item & 7;
    float* GS = lds;
    float* SH = lds + 1024;
    unsigned char* WT = (unsigned char*)lds + NRM_WT_OFF;
    const int lane = tid & 63, wv_ = __builtin_amdgcn_readfirstlane(tid >> 6);
    unsigned char* HB = (unsigned char*)lds + NRM_HB_OFF + wv_ * (4 * NRM_HB_PITCH);
    const int row0 = b * SEQ + sub * 8 + wv_;
    constexpr int RS = 64;
    const bool xbf = (l >= 1);
    const float* xb = P.x + (size_t)row0 * DM;
    const bf16_t* xbb = ((l & 1) ? P.xb0 : P.xb1) + (size_t)row0 * DM;
    const unsigned lo4 = (unsigned)lane * 4u;
    float4 xv[4], rf[2][4]; uint2 rb[2][4];
#define NRM_CVT(dst, raw) do { dst.x = __uint_as_float(raw.x << 16); dst.y = __uint_as_float(raw.x & 0xffff0000u); dst.z = __uint_as_float(raw.y << 16); dst.w = __uint_as_float(raw.y & 0xffff0000u); } while (0)
#define NRM_LOAD(slot, i_) do { _Pragma("unroll") for (int j = 0; j < 4; ++j) { if (xbf) { const ntu2 t_ = LDNT((const ntu2*)((xbb + (size_t)(i_) * RS * DM + j * 256) + lo4)); rb[slot][j].x = t_.x; rb[slot][j].y = t_.y; } \
        else { const ntf4 t_ = LDNT((const ntf4*)((xb + (size_t)(i_) * RS * DM + j * 256) + lo4)); rf[slot][j].x = t_.x; rf[slot][j].y = t_.y; rf[slot][j].z = t_.z; rf[slot][j].w = t_.w; } } } while (0)
    NRM_LOAD(0, 0); NRM_LOAD(1, 1);
    {
        const float* mo = P.mod + ((size_t)(l < NL ? l : 0) * 32 + b) * 3072;
        for (int c = tid; c < DM; c += 512) {
            if (l < NL) { GS[c] = P.norm_g[l * DM + c] * (1.f + mo[1024 + c]); SH[c] = mo[c]; } else { GS[c] = P.final_g[c]; SH[c] = 0.f; }
        }
        if (l < NL) {
            const float* wa = P.w_in + (size_t)l * DM * INW + 1024;
#pragma unroll
            for (int i = 0; i < 2; ++i) {
                const int k = tid + 512 * i;
                const float4 r0 = *(const float4*)(wa + (size_t)k * INW), r1 = *(const float4*)(wa + (size_t)k * INW + 4), r2 = *(const float4*)(wa + (size_t)k * INW + 8), r3 = *(const float4*)(wa + (size_t)k * INW + 12);
                const float rv[16] = {r0.x, r0.y, r0.z, r0.w, r1.x, r1.y, r1.z, r1.w, r2.x, r2.y, r2.z, r2.w, r3.x, r3.y, r3.z, r3.w};
#pragma unroll
                for (int r = 0; r < 16; ++r) *(unsigned short*)(WT + r * NRM_WT_PITCH + k * 2) = (unsigned short)(pk_bf16_rne(rv[r], 0.f) & 0xffffu);
            }
        }
    }
    __syncthreads();
    for (int grp = 0; grp < 8; ++grp) {
#pragma unroll
        for (int rr = 0; rr < 4; ++rr) {
            const int i = grp * 4 + rr;
#pragma unroll
            for (int j = 0; j < 4; ++j) { if (xbf) NRM_CVT(xv[j], rb[rr & 1][j]); else xv[j] = rf[rr & 1][j]; }
            if (i + 2 < 32) NRM_LOAD(rr & 1, i + 2);
            float ss = 0.f;
#pragma unroll
            for (int j = 0; j < 4; ++j) {
                ss += xv[j].x * xv[j].x + xv[j].y * xv[j].y + xv[j].z * xv[j].z + xv[j].w * xv[j].w;
            }
            ss = wave_sum(ss);
            const float rstd = rsqrtf(ss * (1.f / DM) + EPS);
            if (l < NL) {
#pragma unroll
                for (int j = 0; j < 4; ++j) {
                    const float4 g = *(const float4*)(GS + j * 256 + lane * 4), sh = *(const float4*)(SH + j * 256 + lane * 4);
                    uint2 w;
                    w.x = pk_bf16_rne(xv[j].x * rstd * g.x + sh.x, xv[j].y * rstd * g.y + sh.y);
                    w.y = pk_bf16_rne(xv[j].z * rstd * g.z + sh.z, xv[j].w * rstd * g.w + sh.w);
                    *(uint2*)((P.h + (size_t)(row0 + i * RS) * DM + j * 256) + lo4) = w;
                    *(uint2*)(HB + rr * NRM_HB_PITCH + (j * 256 + lane * 4) * 2) = w;
                }
            } else {
#pragma unroll
                for (int j = 0; j < 4; ++j) {
                    const float4 g = *(const float4*)(GS + j * 256 + lane * 4);
                    float4 o; o.x = xv[j].x * rstd * g.x; o.y = xv[j].y * rstd * g.y; o.z = xv[j].z * rstd * g.z; o.w = xv[j].w * rstd * g.w;
                    *(float4*)((P.out + (size_t)(row0 + i * RS) * DM + j * 256) + lo4) = o;
                }
            }
        }
        if (l < NL) {
            nf32x4 acc = {0.f, 0.f, 0.f, 0.f};
            const unsigned char* ap = WT + (lane & 15) * NRM_WT_PITCH + (lane >> 4) * 16;
            const unsigned char* bp = HB + (lane & 3) * NRM_HB_PITCH + (lane >> 4) * 16;
#pragma unroll 8
            for (int s = 0; s < 32; ++s) {
                const nbf16x8 af = *(const nbf16x8*)(ap + 64 * s), bf = *(const nbf16x8*)(bp + 64 * s);
                acc = __builtin_amdgcn_mfma_f32_16x16x32_bf16(af, bf, acc, 0, 0, 0);
            }
            if ((lane & 15) < 4) *(nf32x4*)(P.alr + (size_t)(row0 + (grp * 4 + (lane & 15)) * RS) * 16 + (lane >> 4) * 4) = acc;
        }
    }
    __syncthreads();
}
__device__ __forceinline__ void ph_norm(const Params& P, int l, const int tid, const int bid, float* lds) {
    for (int item = bid; item < 256; item += gridDim.x) norm_item(P, l, item, tid, lds);
}

typedef short mbf16x8 __attribute__((ext_vector_type(8)));
typedef short ms16x4 __attribute__((ext_vector_type(4)));
typedef float mf32x16 __attribute__((ext_vector_type(16)));
typedef float mf32x4 __attribute__((ext_vector_type(4)));
typedef float mf32x2 __attribute__((ext_vector_type(2)));
typedef unsigned mu32x4 __attribute__((ext_vector_type(4)));
typedef unsigned mu32x2 __attribute__((ext_vector_type(2)));
__device__ __forceinline__ unsigned off_b(unsigned row, unsigned ch) { return 256u * row + 16u * (ch ^ (((row & 3u) << 2) | ((row >> 2) & 3u))); }
__device__ __forceinline__ mbf16x8 frag_row(const LAS unsigned char* img, int row0, int cb, int ks, int lane) {
    return *(const LAS mbf16x8*)(img + off_b((unsigned)(row0 + (lane & 31)), (unsigned)(cb + 2 * ks + (lane >> 5))));
}
__device__ __forceinline__ mbf16x8 frag_tr(const LAS unsigned char* img, int row0, int c, int ks, int lane) {
    const unsigned h = lane >> 5, blk = (lane >> 4) & 1, q = (lane & 15) >> 2, p = lane & 3;
    const unsigned r = (unsigned)row0 + 16u * ks + 8u * h + q, chn = 4u * c + 2u * blk + (p >> 1);
    const ms16x4 lo = __builtin_amdgcn_ds_read_tr16_b64_v4i16((LAS ms16x4*)(img + off_b(r, chn) + 8u * (p & 1)));
    const ms16x4 hi = __builtin_amdgcn_ds_read_tr16_b64_v4i16((LAS ms16x4*)(img + off_b(r + 4u, chn) + 8u * (p & 1)));
    return (mbf16x8){lo[0], lo[1], lo[2], lo[3], hi[0], hi[1], hi[2], hi[3]};
}
__device__ __forceinline__ unsigned pk_bf16(float lo, float hi) { unsigned r; asm volatile("v_cvt_pk_bf16_f32 %0, %1, %2" : "=v"(r) : "v"(lo), "v"(hi)); return r; }
__device__ __forceinline__ float bflo(unsigned w) { return __uint_as_float(w << 16); }
__device__ __forceinline__ float bfhi(unsigned w) { return __uint_as_float(w & 0xffff0000u); }
#define WG_BARRIER() __syncthreads()

__device__ __forceinline__ void gla_stream(const Params& P, const int l, const int tid0, const int wgi, LAS unsigned char* lds) {
    const int w = __builtin_amdgcn_readfirstlane(tid0 >> 6);
    const int b = wgi >> 2, hd = wgi & 3;
    const int vt = w & 3, hh = w >> 2;
    LAS unsigned char* QK = lds;
    LAS unsigned char* VI = lds + 16384;
    LAS unsigned char* AI = lds + 32768;
    LAS unsigned char* ST = lds + 49152;
    LAS float* OS = (LAS float*)(lds + 81920);
    LAS float* ALR = (LAS float*)(lds + 114688);
    LAS float* SEG = (LAS float*)(lds + 118784);
    LAS float* EGL = (LAS float*)(lds + 120832);
    LAS float* ZZ = (LAS float*)(lds + 121088);
    mu32x4 w2h, w2l;
    { const unsigned ln = (unsigned)tid0 & 63u; const int zd = (w >> 1) & 1;
      float wv[8];
#pragma unroll
      for (int j = 0; j < 8; ++j) wv[j] = (P.w_alpha2 + ((size_t)l * 16 + j) * 256 + hd * 64 + 32 * zd)[(ln >> 5) * 2048u + (ln & 31u)];
      w2h.x = pk_bf16(wv[0], wv[1]); w2h.y = pk_bf16(wv[2], wv[3]); w2h.z = pk_bf16(wv[4], wv[5]); w2h.w = pk_bf16(wv[6], wv[7]);
      w2l.x = pk_bf16(wv[0] - bflo(w2h.x), wv[1] - bfhi(w2h.x)); w2l.y = pk_bf16(wv[2] - bflo(w2h.y), wv[3] - bfhi(w2h.y));
      w2l.z = pk_bf16(wv[4] - bflo(w2h.z), wv[5] - bfhi(w2h.z)); w2l.w = pk_bf16(wv[6] - bflo(w2h.w), wv[7] - bfhi(w2h.w)); }
    const float bac = (P.b_alpha + l * 256 + hd * 64)[(unsigned)tid0 & 63u];
    float gn[16];
    { const unsigned es = (unsigned)tid0 & 7u;
#pragma unroll
      for (int j = 0; j < 16; ++j) gn[j] = (P.gla_norm_g + l * 512 + hd * 128 + j)[es * 16u]; }
#pragma unroll
    for (int i = 0; i < 4; ++i) *(LAS mu32x4*)(ST + (tid0 + 512 * i) * 16) = (mu32x4){0u, 0u, 0u, 0u};
    mf32x16 acc6;
#pragma unroll
    for (int i = 0; i < 16; ++i) acc6[i] = 0.f;
    const bf16_t* pb = P.p + (size_t)b * SEQ * PW;
    const float* ab = P.alr + (size_t)b * SEQ * 16;
    bf16_t* cbp = P.cat + (size_t)b * SEQ * DM + hd * 128;
    unsigned short qvA[8], kvA[8], qvB[8], kvB[8]; mf32x2 alA, alB; mu32x4 vvA[2], rvA[2], vvB[2], rvB[2];
#define GLA_ZTILE(lane_) do { const int zt_ = w & 1, zd_ = (w >> 1) & 1; \
        const LAS mf32x4* ap_ = (const LAS mf32x4*)(ALR + (32 * zt_ + ((lane_) & 31)) * 16 + 8 * ((lane_) >> 5)); \
        const mf32x4 a0_ = ap_[0], a1_ = ap_[1]; \
        mu32x4 ah_, al_; \
        ah_.x = pk_bf16(a0_[0], a0_[1]); ah_.y = pk_bf16(a0_[2], a0_[3]); ah_.z = pk_bf16(a1_[0], a1_[1]); ah_.w = pk_bf16(a1_[2], a1_[3]); \
        al_.x = pk_bf16(a0_[0] - bflo(ah_.x), a0_[1] - bfhi(ah_.x)); al_.y = pk_bf16(a0_[2] - bflo(ah_.y), a0_[3] - bfhi(ah_.y)); \
        al_.z = pk_bf16(a1_[0] - bflo(ah_.z), a1_[1] - bfhi(ah_.z)); al_.w = pk_bf16(a1_[2] - bflo(ah_.w), a1_[3] - bfhi(ah_.w)); \
        mf32x16 z_; \
_Pragma("unroll") \
        for (int i_ = 0; i_ < 16; ++i_) z_[i_] = 0.f; \
        z_ = __builtin_amdgcn_mfma_f32_32x32x16_bf16(__builtin_bit_cast(mbf16x8, al_), __builtin_bit_cast(mbf16x8, w2h), z_, 0, 0, 0); \
        z_ = __builtin_amdgcn_mfma_f32_32x32x16_bf16(__builtin_bit_cast(mbf16x8, ah_), __builtin_bit_cast(mbf16x8, w2l), z_, 0, 0, 0); \
        z_ = __builtin_amdgcn_mfma_f32_32x32x16_bf16(__builtin_bit_cast(mbf16x8, ah_), __builtin_bit_cast(mbf16x8, w2h), z_, 0, 0, 0); \
        LAS float* zp_ = ZZ + (32 * zt_ + 4 * ((lane_) >> 5)) * 64 + 32 * zd_ + ((lane_) & 31); \
_Pragma("unroll") \
        for (int r_ = 0; r_ < 16; ++r_) zp_[((r_ & 3) + 8 * (r_ >> 2)) * 64] = z_[r_]; } while (0)
#define GLA_LOAD_QK(c, lane_, q_, k_) do { _Pragma("unroll") for (int i = 0; i < 8; ++i) { const bf16_t* rp = pb + (size_t)((c) * 64 + 8 * w + i) * PW + hd * 64; q_[i] = LDNT(rp + (unsigned)(lane_)); k_[i] = LDNT(rp + 256 + (unsigned)(lane_)); } } while (0)
#define GLA_LOAD_A(c, tid_, a_) do { a_ = LDNT((const mf32x2*)((ab + (size_t)(c) * 64 * 16) + (unsigned)(tid_) * 2u)); } while (0)
#define GLA_LOAD_AV(c, tid_, a_, v_) do { (void)(a_); \
        const unsigned vo_ = ((unsigned)(tid_) >> 4) * (unsigned)PW + ((unsigned)(tid_) & 15u) * 8u; \
        _Pragma("unroll") for (int i = 0; i < 2; ++i) v_[i] = LDNT((const mu32x4*)((pb + (size_t)((c) * 64 + 32 * i) * PW + 512 + hd * 128) + vo_)); } while (0)
#define GLA_LOAD_R(c, tid_, r_) do { const unsigned ro_ = ((unsigned)(tid_) >> 3) * (unsigned)PW + ((unsigned)(tid_) & 7u) * 16u; \
        _Pragma("unroll") for (int i = 0; i < 2; ++i) r_[i] = LDNT((const mu32x4*)((pb + (size_t)(c) * 64 * PW + 1024 + hd * 128 + 8 * i) + ro_)); } while (0)
    GLA_LOAD_A(0, tid0, alA); GLA_LOAD_A(1, tid0, alB);
    GLA_LOAD_AV(0, tid0, alA, vvA); GLA_LOAD_QK(0, tid0 & 63, qvA, kvA); GLA_LOAD_R(0, tid0, rvA);
    GLA_LOAD_AV(1, tid0, alB, vvB); GLA_LOAD_QK(1, tid0 & 63, qvB, kvB); GLA_LOAD_R(1, tid0, rvB);
    *(LAS mf32x2*)(ALR + tid0 * 2) = alA;
    GLA_LOAD_A(2, tid0, alA);
    WG_BARRIER();
    if (w >= 4) GLA_ZTILE(tid0 & 63);
    WG_BARRIER();
#define GLA_CHUNK(C, S, T) do { const int c = (C); \
        const int tid = opaque_v(tid0);                   \
        const int lane = tid & 63, lh = lane >> 5, l31 = lane & 31; \
          \
        if (c + 1 < SEQ / 64) *(LAS mf32x2*)(ALR + tid * 2) = al##T; \
_Pragma("unroll") \
        for (int i = 0; i < 2; ++i) *(LAS mu32x4*)(VI + off_b((unsigned)(tid >> 4), (unsigned)(tid & 15)) + 8192 * i) = vv##S[i]; \
          \
        float Gl[8]; float cum = 0.f; float zr[8]; \
_Pragma("unroll") \
        for (int i = 0; i < 8; ++i) zr[i] = ZZ[(8 * w + i) * 64 + lane]; \
_Pragma("unroll") \
        for (int i = 0; i < 8; ++i) { \
            const float z = bac + zr[i]; \
            const float e = __builtin_amdgcn_exp2f(-1.4426950408889634f * fabsf(z)); \
            const float ls = fminf(z, 0.f) - 0.6931471805599453f * __builtin_amdgcn_logf(1.0f + e);     \
            cum += ls * (1.0f / 16.0f); \
            Gl[i] = cum; \
        } \
        SEG[w * 64 + lane] = cum; \
        WG_BARRIER(); \
        if (c + 2 < SEQ / 64) GLA_LOAD_AV(c + 2, tid, al##S, vv##S); \
        if (c + 3 < SEQ / 64) GLA_LOAD_A(c + 3, tid, al##T); \
        float pre = 0.f; \
_Pragma("unroll") \
        for (int ww = 0; ww < 7; ++ww) { const float sv = SEG[ww * 64 + lane]; pre += (ww < w) ? sv : 0.f; }     \
        if (w == 7) EGL[lane] = __builtin_amdgcn_exp2f(1.4426950408889634f * (pre + Gl[7])); \
        { \
            const unsigned qoff = off_b((unsigned)(8 * w), (unsigned)(lane >> 3)) + (lane & 7) * 2;         \
_Pragma("unroll") \
            for (int i = 0; i < 8; ++i) { \
                const float G = (pre + Gl[i]) * 1.4426950408889634f; \
                const float qt = __uint_as_float(((unsigned)qv##S[i]) << 16) * __builtin_amdgcn_exp2f(G); \
                const float kt = __uint_as_float(((unsigned)kv##S[i]) << 16) * __builtin_amdgcn_exp2f(-G); \
                const unsigned t = 8 * w + i; \
                (void)qoff; \
                *(LAS unsigned short*)(QK + off_b(t, (unsigned)(lane >> 3)) + (lane & 7) * 2) = (unsigned short)(pk_bf16(qt, 0.f) & 0xffffu); \
                *(LAS unsigned short*)(QK + off_b(t, 8u + (unsigned)(lane >> 3)) + (lane & 7) * 2) = (unsigned short)(pk_bf16(kt, 0.f) & 0xffffu); \
            } \
        } \
        WG_BARRIER(); \
        if (c + 2 < SEQ / 64) GLA_LOAD_QK(c + 2, lane, qv##S, kv##S); \
          \
        mbf16x8 vf[4]; \
_Pragma("unroll") \
        for (int ks = 0; ks < 4; ++ks) vf[ks] = frag_tr(VI, 0, vt, ks, lane); \
_Pragma("unroll") \
        for (int ks = 0; ks < 4; ++ks) { const mbf16x8 kf = frag_tr(QK, 0, 2 + hh, ks, lane); acc6 = __builtin_amdgcn_mfma_f32_32x32x16_bf16(kf, vf[ks], acc6, 0, 0, 0); } \
        if (w >= 4 && c + 1 < SEQ / 64) GLA_ZTILE(lane); \
        if (w < 3) { \
            const int tt = (w == 0) ? 0 : 1, st = (w == 2) ? 1 : 0; \
            mf32x16 a4; \
_Pragma("unroll") \
            for (int i = 0; i < 16; ++i) a4[i] = 0.f; \
_Pragma("unroll") \
            for (int ks = 0; ks < 4; ++ks) { const mbf16x8 ka = frag_row(QK, 32 * st, 8, ks, lane), qb = frag_row(QK, 32 * tt, 0, ks, lane); a4 = __builtin_amdgcn_mfma_f32_32x32x16_bf16(ka, qb, a4, 0, 0, 0); } \
              \
            const int t = 32 * tt + l31; \
_Pragma("unroll") \
            for (int g = 0; g < 4; ++g) { const int s0 = 32 * st + 8 * g + 4 * lh; \
                const float x0 = (s0 + 0 <= t) ? a4[4 * g + 0] : 0.f, x1 = (s0 + 1 <= t) ? a4[4 * g + 1] : 0.f, x2 = (s0 + 2 <= t) ? a4[4 * g + 2] : 0.f, x3 = (s0 + 3 <= t) ? a4[4 * g + 3] : 0.f; \
                mu32x2 wv; wv.x = pk_bf16(x0, x1); wv.y = pk_bf16(x2, x3); \
                *(LAS mu32x2*)(AI + off_b((unsigned)t, (unsigned)(4 * st + g)) + 8 * lh) = wv; } \
        } \
        WG_BARRIER(); \
          \
        { \
            mf32x16 a5; \
_Pragma("unroll") \
            for (int i = 0; i < 16; ++i) a5[i] = 0.f; \
_Pragma("unroll") \
            for (int ks = 0; ks < 4; ++ks) if (ks < 2 || hh == 1) { const mbf16x8 af = frag_row(AI, 32 * hh, 0, ks, lane); a5 = __builtin_amdgcn_mfma_f32_32x32x16_bf16(af, vf[ks], a5, 0, 0, 0); } \
_Pragma("unroll") \
            for (int ks = 0; ks < 4; ++ks) { const mbf16x8 qf = frag_row(QK, 32 * hh, 0, ks, lane), sf = frag_row(ST, 32 * vt, 0, ks, lane); a5 = __builtin_amdgcn_mfma_f32_32x32x16_bf16(qf, sf, a5, 0, 0, 0); } \
            LAS float* ob = OS + (32 * hh + 4 * lh) * 128 + 32 * vt + l31; \
_Pragma("unroll") \
            for (int r = 0; r < 16; ++r) ob[((r & 3) + 8 * (r >> 2)) * 128] = a5[r]; \
        } \
_Pragma("unroll") \
        for (int g = 0; g < 4; ++g) { const mf32x4 e4 = *(const LAS mf32x4*)(EGL + 32 * hh + 8 * g + 4 * lh); \
            acc6[4 * g + 0] *= e4[0]; acc6[4 * g + 1] *= e4[1]; acc6[4 * g + 2] *= e4[2]; acc6[4 * g + 3] *= e4[3]; } \
        WG_BARRIER(); \
          \
_Pragma("unroll") \
        for (int g = 0; g < 4; ++g) { mu32x2 wv; wv.x = pk_bf16(acc6[4 * g + 0], acc6[4 * g + 1]); wv.y = pk_bf16(acc6[4 * g + 2], acc6[4 * g + 3]); \
            *(LAS mu32x2*)(ST + off_b((unsigned)(32 * vt + l31), (unsigned)(4 * hh + g)) + 8 * lh) = wv; } \
        { \
            const unsigned et = (unsigned)tid >> 3, es = (unsigned)tid & 7u; \
            const LAS mf32x4* op = (const LAS mf32x4*)(OS + et * 128 + es * 16); \
            const mf32x4 o0 = op[0], o1 = op[1], o2 = op[2], o3 = op[3]; \
            float ss = o0[0] * o0[0] + o0[1] * o0[1] + o0[2] * o0[2] + o0[3] * o0[3] + o1[0] * o1[0] + o1[1] * o1[1] + o1[2] * o1[2] + o1[3] * o1[3] \
                     + o2[0] * o2[0] + o2[1] * o2[1] + o2[2] * o2[2] + o2[3] * o2[3] + o3[0] * o3[0] + o3[1] * o3[1] + o3[2] * o3[2] + o3[3] * o3[3]; \
            ss = red8(ss); \
            const float rs = rsqrtf(ss * (1.0f / 128.0f) + EPS); \
            mu32x4 w0, w1; \
            w0.x = pk_bf16(o0[0] * rs * gn[0] * bflo(rv##S[0].x), o0[1] * rs * gn[1] * bfhi(rv##S[0].x)); \
            w0.y = pk_bf16(o0[2] * rs * gn[2] * bflo(rv##S[0].y), o0[3] * rs * gn[3] * bfhi(rv##S[0].y)); \
            w0.z = pk_bf16(o1[0] * rs * gn[4] * bflo(rv##S[0].z), o1[1] * rs * gn[5] * bfhi(rv##S[0].z)); \
            w0.w = pk_bf16(o1[2] * rs * gn[6] * bflo(rv##S[0].w), o1[3] * rs * gn[7] * bfhi(rv##S[0].w)); \
            w1.x = pk_bf16(o2[0] * rs * gn[8] * bflo(rv##S[1].x), o2[1] * rs * gn[9] * bfhi(rv##S[1].x)); \
            w1.y = pk_bf16(o2[2] * rs * gn[10] * bflo(rv##S[1].y), o2[3] * rs * gn[11] * bfhi(rv##S[1].y)); \
            w1.z = pk_bf16(o3[0] * rs * gn[12] * bflo(rv##S[1].z), o3[1] * rs * gn[13] * bfhi(rv##S[1].z)); \
            w1.w = pk_bf16(o3[2] * rs * gn[14] * bflo(rv##S[1].w), o3[3] * rs * gn[15] * bfhi(rv##S[1].w)); \
            bf16_t* du = cbp + (size_t)c * 64 * DM;                          \
            const unsigned doff = et * (unsigned)DM + es * 16u; \
            store16_wt(du, doff * 2u, w0); store16_wt(du, doff * 2u + 16u, w1);        \
        } \
        if (c == 3) publish_count_wt(seam_cnt(P.ctl, l, b, 0), 1, tid);         \
        if (c == 7) publish_count_wt(seam_cnt(P.ctl, l, b, 1), 1, tid); \
        if (c == 11) publish_count_wt(seam_cnt(P.ctl, l, b, 2), 1, tid); \
        if (c == 23) publish_count_wt(seam_cnt(P.ctl, l, b, 3), 3, tid);        \
        if (c == 27) publish_count_wt(seam_cnt(P.ctl, l, b, 6), 1, tid);        \
        if (c + 2 < SEQ / 64) GLA_LOAD_R(c + 2, tid, rv##S); \
    } while (0)
    for (int c2 = 0; c2 < SEQ / 128; ++c2) {
        GLA_CHUNK(2 * c2, A, B);
        GLA_CHUNK(2 * c2 + 1, B, A);
    }
#undef GLA_CHUNK
    publish_count_wt(seam_cnt(P.ctl, l, b, 7), 1, tid0);
#undef GLA_LOAD_QK
#undef GLA_ZTILE
#undef GLA_LOAD_AV
#undef GLA_LOAD_A
#undef GLA_LOAD_R
}

template <int NKS> __device__ __forceinline__ void sg_mfma(const LAS unsigned char* WI, const LAS unsigned char* VN, LAS float* MX, const int tc0, const int lane) {
    constexpr int tr = NKS / 2 - 1;
    mbf16x8 af[NKS], b0[NKS], b1[NKS];
#pragma unroll
    for (int ks = 0; ks < NKS; ++ks) { af[ks] = frag_row(WI, 32 * tr, 0, ks, lane); b0[ks] = frag_tr(VN, 0, tc0, ks, lane); b1[ks] = frag_tr(VN, 0, tc0 + 1, ks, lane); }
    mf32x16 m0, m1;
#pragma unroll
    for (int i = 0; i < 16; ++i) { m0[i] = 0.f; m1[i] = 0.f; }
#pragma unroll
    for (int ks = 0; ks < NKS; ++ks) { m0 = __builtin_amdgcn_mfma_f32_32x32x16_bf16(af[ks], b0[ks], m0, 0, 0, 0); m1 = __builtin_amdgcn_mfma_f32_32x32x16_bf16(af[ks], b1[ks], m1, 0, 0, 0); }
    const int lh = lane >> 5, l31 = lane & 31;
    LAS float* mb = MX + (32 * tr + 4 * lh) * 128 + 32 * tc0 + l31;
#pragma unroll
    for (int r = 0; r < 16; ++r) { mb[((r & 3) + 8 * (r >> 2)) * 128] = m0[r]; mb[((r & 3) + 8 * (r >> 2)) * 128 + 32] = m1[r]; }
}
__device__ __forceinline__ void sg_stream(const Params& P, const int l, const int tid0, const int wgi, LAS unsigned char* lds) {
    const int w = __builtin_amdgcn_readfirstlane(tid0 >> 6);
    const int g = wgi & 3, cbase = (wgi >> 2) * 16;
    LAS unsigned char* WI = lds;
    LAS unsigned char* VN = lds + 32768;
    LAS float* MX = (LAS float*)(lds + 65536);
    {
        const int lr = tid0 >> 4, ch = tid0 & 15;
        const float* wu = P.w_spatial + ((size_t)l * 4 + g) * 128 * 128;
#pragma unroll
        for (int i = 0; i < 4; ++i) {
            const int row = lr + 32 * i;
            const float* wp = wu + (unsigned)(row * 128 + ch * 8);
            const float4 a = *(const float4*)wp, bq = *(const float4*)(wp + 4);
            const int s0 = ch * 8;
            mu32x4 wv;
            wv.x = pk_bf16(s0 + 0 <= row ? a.x : 0.f, s0 + 1 <= row ? a.y : 0.f); wv.y = pk_bf16(s0 + 2 <= row ? a.z : 0.f, s0 + 3 <= row ? a.w : 0.f);
            wv.z = pk_bf16(s0 + 4 <= row ? bq.x : 0.f, s0 + 5 <= row ? bq.y : 0.f); wv.w = pk_bf16(s0 + 6 <= row ? bq.z : 0.f, s0 + 7 <= row ? bq.w : 0.f);
            *(LAS mu32x4*)(WI + off_b((unsigned)lr, (unsigned)ch) + 8192 * i) = wv;
        }
    }
    float lg[8], lb[8], bs[4];
    { const unsigned ch = (unsigned)tid0 & 15u, lr = (unsigned)tid0 >> 4;
#pragma unroll
      for (int j = 0; j < 8; ++j) { lg[j] = (P.sg_ln_g + l * 512 + g * 128 + j)[ch * 8u]; lb[j] = (P.sg_ln_b + l * 512 + g * 128 + j)[ch * 8u]; }
#pragma unroll
      for (int i = 0; i < 4; ++i) bs[i] = (P.b_spatial + ((size_t)l * 4 + g) * 128 + 32 * i)[lr]; }
    mu32x4 vA[4], uA[4], vB[4], uB[4];
#define SG_LOAD(dst, chunk, col0, tid_) do { const unsigned so_ = ((unsigned)(tid_) >> 4) * (unsigned)PW + ((unsigned)(tid_) & 15u) * 8u; \
        _Pragma("unroll") for (int i = 0; i < 4; ++i) dst[i] = LDNT((const mu32x4*)((P.p + (size_t)((chunk) * 128 + 32 * i) * PW + (col0) + g * 128) + so_)); } while (0)
    SG_LOAD(vA, cbase, 2048, tid0); SG_LOAD(uA, cbase, 1536, tid0);
    SG_LOAD(vB, cbase + 1, 2048, tid0); SG_LOAD(uB, cbase + 1, 1536, tid0);
    const int tr = w >> 1, tc0 = (w & 1) * 2;
#define SG_UNIT(IT, vv, uv) do { \
        const int it = (IT); const int chunk = cbase + it; \
        const int tid = opaque_v(tid0); \
        const int lane = tid & 63, lh = lane >> 5, l31 = lane & 31, lr = tid >> 4, ch = tid & 15; \
          \
        { \
            LAS unsigned char* vb = VN + off_b((unsigned)lr, (unsigned)ch); \
            _Pragma("unroll") for (int i = 0; i < 4; ++i) { \
                float x[8] = {bflo(vv[i].x), bfhi(vv[i].x), bflo(vv[i].y), bfhi(vv[i].y), bflo(vv[i].z), bfhi(vv[i].z), bflo(vv[i].w), bfhi(vv[i].w)}; \
                float s = ((x[0] + x[1]) + (x[2] + x[3])) + ((x[4] + x[5]) + (x[6] + x[7])); \
                s = red16(s); \
                const float mu = s * (1.0f / 128.0f); \
                float q = 0.f; \
                _Pragma("unroll") for (int j = 0; j < 8; ++j) { x[j] -= mu; q += x[j] * x[j]; } \
                q = red16(q); \
                const float rs = rsqrtf(q * (1.0f / 128.0f) + EPS); \
                mu32x4 wv; \
                wv.x = pk_bf16(x[0] * rs * lg[0] + lb[0], x[1] * rs * lg[1] + lb[1]); wv.y = pk_bf16(x[2] * rs * lg[2] + lb[2], x[3] * rs * lg[3] + lb[3]); \
                wv.z = pk_bf16(x[4] * rs * lg[4] + lb[4], x[5] * rs * lg[5] + lb[5]); wv.w = pk_bf16(x[6] * rs * lg[6] + lb[6], x[7] * rs * lg[7] + lb[7]); \
                *(LAS mu32x4*)(vb + 8192 * i) = wv; \
            } \
        } \
        WG_BARRIER(); \
        if (it + 2 < 16) SG_LOAD(vv, chunk + 2, 2048, tid); \
          \
        if (tr == 0) sg_mfma<2>(WI, VN, MX, tc0, lane); else if (tr == 1) sg_mfma<4>(WI, VN, MX, tc0, lane); else if (tr == 2) sg_mfma<6>(WI, VN, MX, tc0, lane); else sg_mfma<8>(WI, VN, MX, tc0, lane); \
        WG_BARRIER(); \
          \
        { \
            bf16_t* cu = P.cat + (size_t)chunk * 128 * DM + 512 + g * 128; \
            const unsigned co = (unsigned)lr * (unsigned)DM + (unsigned)ch * 8u; \
            const LAS float* mr = MX + lr * 128 + ch * 8; \
            _Pragma("unroll") for (int i = 0; i < 4; ++i) { \
                const LAS mf32x4* mp = (const LAS mf32x4*)(mr + 32 * 128 * i); \
                const mf32x4 ma = mp[0], mb = mp[1]; \
                mu32x4 wv; \
                wv.x = pk_bf16(bflo(uv[i].x) * (ma[0] + bs[i]), bfhi(uv[i].x) * (ma[1] + bs[i])); \
                wv.y = pk_bf16(bflo(uv[i].y) * (ma[2] + bs[i]), bfhi(uv[i].y) * (ma[3] + bs[i])); \
                wv.z = pk_bf16(bflo(uv[i].z) * (mb[0] + bs[i]), bfhi(uv[i].z) * (mb[1] + bs[i])); \
                wv.w = pk_bf16(bflo(uv[i].w) * (mb[2] + bs[i]), bfhi(uv[i].w) * (mb[3] + bs[i])); \
                store16_wt(cu + (size_t)32 * i * DM, co * 2u, wv); \
            } \
        } \
        if (it == 7) publish_count_wt(seam_cnt(P.ctl, l, wgi >> 2, 0), 4, tid);            \
        if (it == 15) publish_count_wt(seam_cnt(P.ctl, l, wgi >> 2, 4), 4, tid);           \
        if (it + 2 < 16) SG_LOAD(uv, chunk + 2, 1536, tid); \
    } while (0)
    for (int it2 = 0; it2 < 8; ++it2) {
        SG_UNIT(2 * it2, vA, uA);
        SG_UNIT(2 * it2 + 1, vB, uB);
    }
#undef SG_UNIT
    WG_BARRIER();
#undef SG_LOAD
}
__device__ __forceinline__ void ph_mixers(const Params& P, const int l, const int tid, const int bid, LAS unsigned char* lds) {
    for (int item = bid; item < 256; item += gridDim.x) {
        if (item < 128) gla_stream(P, l, tid, item, lds);
        else sg_stream(P, l, tid, item - 128, lds);
    }
}

#define PHASE_IDS() int lane__; asm volatile("v_mbcnt_lo_u32_b32 %0, -1, 0\n\tv_mbcnt_hi_u32_b32 %0, -1, %0" : "=v"(lane__)); \
    const int tid = opaque_s(wave_s) * 64 + lane__; const int bid = opaque_s((int)blockIdx.x); (void)tid; (void)bid
__global__ void __launch_bounds__(512, 2) fwd_megakernel(Params P) {
    extern __shared__ __attribute__((aligned(16))) unsigned char smem[];
    float* lds = (float*)smem;
    cg::grid_group grid = cg::this_grid();
    const int wave_s = __builtin_amdgcn_readfirstlane((int)threadIdx.x >> 6);
    volatile LAS unsigned* misc = (volatile LAS unsigned*)((LAS unsigned char*)smem + MISC_OFF);
    if (threadIdx.x < 32) misc[threadIdx.x] = 0u;
    __syncthreads();
    const XcdBarrier bar = xcd_barrier_post(P.ctl, misc + 8);
    { PHASE_IDS(); ph_prologue(P, lds, tid, bid, 0); }
    grid.sync();
    for (int l = 0; l < NL; ++l) {
        { PHASE_IDS(); ph_norm(P, l, tid, bid, lds); if (l == 0) { __syncthreads(); ph_prologue(P, lds, tid, bid, 1); } }
        xcd_barrier(bar);
        { PHASE_IDS();
          pg8::Gemm g{P.h, P.wt_in + (size_t)l * NWT * DM, NT, NWT, DM}; pg8::StaticOrder S; S.init(NT, NWT, (int)gridDim.x, bid);
          pg8::EpiInprojMF e{P.p};
          pg8::gemm_phase<pg8::EpiInprojMF, pg8::StaticOrder, true, true>((PG8_LAS unsigned char*)smem, g, S, e, tid); }
        xcd_barrier(bar);
        { PHASE_IDS(); ph_mixers(P, l, tid, bid, (LAS unsigned char*)smem); }
        {
            PHASE_IDS();
            const bool isg = (bid < 128);
            const int ow = isg ? bid : (bid - 128); const int ob = ow & 31, opn = ow >> 5, oj0 = isg ? 5 : 0, on = isg ? 2 : 6;
            pg8::Gemm g{P.cat, P.wt_out + (size_t)l * DM * DM, NT, DM, DM};
            pg8::PanelOrder S{ob * 8 + oj0, on, opn, seam_cnt(P.ctl, l, ob, oj0), 8u, isg ? 99 : 5, isg ? 0 : 2};
            const float* gate = P.mod + (size_t)l * 32 * 3072 + 2048; bf16_t* xo = (l & 1) ? P.xb1 : P.xb0; const bf16_t* xi = (l & 1) ? P.xb0 : P.xb1;
            if (l == NL - 1) { pg8::EpiOutprojFinal e{xi, P.out, gate, P.final_g, (float*)((unsigned char*)P.ctl + CTL_BYTES), (PG8_LAS float*)((PG8_LAS unsigned char*)smem + 131072)};
                pg8::gemm_phase<pg8::EpiOutprojFinal, pg8::PanelOrder, true, true>((PG8_LAS unsigned char*)smem, g, S, e, tid); }
            else if (l == 0) { pg8::EpiOutprojRes<true> e{P.x, nullptr, xo, gate}; pg8::gemm_phase<pg8::EpiOutprojRes<true>, pg8::PanelOrder, true, true>((PG8_LAS unsigned char*)smem, g, S, e, tid); }
            else { pg8::EpiOutprojRes<false> e{nullptr, xi, xo, gate}; pg8::gemm_phase<pg8::EpiOutprojRes<false>, pg8::PanelOrder, true, true>((PG8_LAS unsigned char*)smem, g, S, e, tid); }
        }
        if (l + 1 < NL) xcd_barrier(bar);
    }
}

static inline size_t align_up(size_t v, size_t a) { return (v + a - 1) / a * a; }
extern "C" void kernel_launch(void* const* d_in, const int* in_sizes, int n_in, void* d_out, int out_size, void* d_ws, size_t ws_size, hipStream_t stream) {
    constexpr size_t kDynLds = LDS_BYTES;
    static int grid_blocks = 0;
    if (!grid_blocks) {
        int dev = 0, cus = 0, per_cu = 0;
        (void)hipGetDevice(&dev);
        (void)hipDeviceGetAttribute(&cus, hipDeviceAttributeMultiprocessorCount, dev);
        (void)hipFuncSetAttribute((const void*)fwd_megakernel, hipFuncAttributeMaxDynamicSharedMemorySize, (int)kDynLds);
        (void)hipOccupancyMaxActiveBlocksPerMultiprocessor(&per_cu, (const void*)fwd_megakernel, 512, kDynLds);
        if (per_cu < 1) per_cu = 1;
        if (per_cu > 1) per_cu = 1;
        grid_blocks = cus * per_cu;
        if (grid_blocks != 256) fprintf(stderr, "kernel_launch: this kernel's phase program is laid out for 256 workgroups (one per CU of an MI355X); got %d\n", grid_blocks);
    }
    Params p{};
    p.x = (const float*)d_in[0]; p.c = (const float*)d_in[1]; p.norm_g = (const float*)d_in[2]; p.w_ada = (const float*)d_in[3]; p.b_ada = (const float*)d_in[4];
    p.w_in = (const float*)d_in[5]; p.w_alpha2 = (const float*)d_in[6]; p.b_alpha = (const float*)d_in[7]; p.gla_norm_g = (const float*)d_in[8];
    p.sg_ln_g = (const float*)d_in[9]; p.sg_ln_b = (const float*)d_in[10]; p.w_spatial = (const float*)d_in[11]; p.b_spatial = (const float*)d_in[12];
    p.w_out = (const float*)d_in[13]; p.final_g = (const float*)d_in[14];
    p.out = (float*)d_out;
    unsigned char* ws = (unsigned char*)d_ws; size_t off = 0;
    auto carve = [&](size_t bytes) { void* r = ws + off; off = align_up(off + bytes, 256); return r; };
    p.ctl = (unsigned*)carve(CTL_BYTES + XCH_BYTES);
    p.mod = (float*)carve((size_t)NL * 32 * 3072 * 4);
    p.wt_in = (bf16_t*)carve((size_t)NL * NWT * DM * 2);
    p.wt_out = (bf16_t*)carve((size_t)NL * DM * DM * 2);
    p.h = (bf16_t*)carve((size_t)NT * DM * 2);
    p.p = (bf16_t*)carve((size_t)NT * PW * 2);
    p.alr = (float*)carve((size_t)NT * 16 * 4);
    p.cat = (bf16_t*)carve((size_t)NT * DM * 2);
    p.xb0 = (bf16_t*)carve((size_t)NT * DM * 2);
    p.xb1 = (bf16_t*)carve((size_t)NT * DM * 2);
    if (off > ws_size) { fprintf(stderr, "kernel_launch: workspace too small: need %zu have %zu\n", off, ws_size); return; }
    (void)hipMemsetAsync(p.ctl, 0, CTL_BYTES + XCH_BYTES, stream);
    void* args[] = {&p};
    hipError_t e = hipLaunchCooperativeKernel((const void*)fwd_megakernel, dim3(grid_blocks), dim3(512), args, kDynLds, stream);
    if (e != hipSuccess) fprintf(stderr, "cooperative launch failed: %s (grid %d)\n", hipGetErrorString(e), grid_blocks);
}
```
